# Optimizing an MI355X kernel written in HIP

```python
import jax, jax.numpy as jnp
from jax import lax
import numpy as np

D_MODEL = 1024
BATCH = 8
SEQ = 8192
DEPTH = 4

D_MIX = D_MODEL
D_MLSTM = D_MIX // 2
D_CONV = D_MIX - D_MLSTM
N_MLSTM_HEADS = 4
HEAD_DIM = D_MLSTM // N_MLSTM_HEADS
CONV_WIDTH = 3
CHUNK = 128
N_EXPERTS = 16
N_GROUPS = 4
EXPERTS_PER_GROUP = N_EXPERTS // N_GROUPS
TOP_K = 2
D_FF_EXPERT = D_MODEL // 2
EXPERT_BLOCK = 128
LN_EPS = 1e-5
ALPHA = (2 * DEPTH) ** 0.25
BETA = (8 * DEPTH) ** -0.25

OFF_Q = 0
OFF_K = OFF_Q + D_MLSTM
OFF_V = OFF_K + D_MLSTM
OFF_O = OFF_V + D_MLSTM
OFF_I = OFF_O + D_MLSTM
OFF_F = OFF_I + N_MLSTM_HEADS
OFF_B = OFF_F + N_MLSTM_HEADS
OFF_C = OFF_B + D_CONV
OFF_X = OFF_C + D_CONV
P_IN = OFF_X + D_CONV

kernel_name = "hybrid_mlstm_shortconv_grouped_moe_deepnorm"


def layer_norm(x, g, b):
    xf = x.astype(jnp.float32)
    mu = xf.mean(-1, keepdims=True)
    var = jnp.square(xf - mu).mean(-1, keepdims=True)
    return ((xf - mu) * lax.rsqrt(var + LN_EPS) * g.astype(jnp.float32) + b.astype(jnp.float32)).astype(x.dtype)


def mlstm_cell(q, k, v, i_pre, f_pre):
    b, s, h, dh = q.shape
    nc = s // CHUNK
    f32 = jnp.float32

    def chunks(t):
        return t.astype(f32).reshape(b, nc, CHUNK, h, -1).transpose(0, 3, 1, 2, 4)

    q = chunks(q)
    k = chunks(k) * (dh ** -0.5)
    v = chunks(v)
    ig = chunks(i_pre[..., None])[..., 0]
    logf = jax.nn.log_sigmoid(chunks(f_pre[..., None])[..., 0])
    a = jnp.cumsum(logf, axis=-1)
    g = a[..., -1]

    w_end = g[..., None] - a + ig
    m_loc = w_end.max(-1)
    e_end = jnp.exp(w_end - m_loc[..., None])
    c_loc = jnp.einsum('bhcsk,bhcsv->bhckv', k * e_end[..., None], v)
    n_loc = jnp.einsum('bhcs,bhcsk->bhck', e_end, k)

    def step(carry, xs):
        c_prev, n_prev, m_prev = carry
        c_l, n_l, m_l, g_c = xs
        m_new = jnp.maximum(g_c + m_prev, m_l)
        s_prev = jnp.exp(g_c + m_prev - m_new)
        s_loc = jnp.exp(m_l - m_new)
        c_new = s_prev[..., None, None] * c_prev + s_loc[..., None, None] * c_l
        n_new = s_prev[..., None] * n_prev + s_loc[..., None] * n_l
        return (c_new, n_new, m_new), (c_prev, n_prev, m_prev)

    init = (jnp.zeros((b, h, dh, dh), f32), jnp.zeros((b, h, dh), f32), jnp.zeros((b, h), f32))
    xs = (jnp.moveaxis(c_loc, 2, 0), jnp.moveaxis(n_loc, 2, 0), jnp.moveaxis(m_loc, 2, 0), jnp.moveaxis(g, 2, 0))
    _, (c_st, n_st, m_st) = lax.scan(step, init, xs)
    c_st = jnp.moveaxis(c_st, 0, 2)
    n_st = jnp.moveaxis(n_st, 0, 2)
    m_st = jnp.moveaxis(m_st, 0, 2)

    causal = jnp.tril(jnp.ones((CHUNK, CHUNK), dtype=bool))
    log_d = jnp.where(causal, a[..., :, None] - a[..., None, :] + ig[..., None, :], -jnp.inf)
    log_inter = a + m_st[..., None]
    m_out = jnp.maximum(log_inter, log_d.max(-1))
    dmat = jnp.exp(log_d - m_out[..., None])
    s_qk = jnp.einsum('bhcjd,bhcsd->bhcjs', q, k) * dmat
    e_inter = jnp.exp(log_inter - m_out)
    num = jnp.einsum('bhcjs,bhcsv->bhcjv', s_qk, v) + e_inter[..., None] * jnp.einsum('bhcjk,bhckv->bhcjv', q, c_st)
    den = s_qk.sum(-1) + e_inter * jnp.einsum('bhcjk,bhck->bhcj', q, n_st)
    h_t = num / jnp.maximum(jnp.abs(den), jnp.exp(-m_out))[..., None]
    return h_t.transpose(0, 2, 3, 1, 4).reshape(b, s, h, dh)


def hybrid_mixer(x, w_in, b_in, conv_w, mh_g, w_out):
    b, s, _ = x.shape
    p = x @ w_in + b_in
    q = p[..., OFF_Q:OFF_K].reshape(b, s, N_MLSTM_HEADS, HEAD_DIM)
    k = p[..., OFF_K:OFF_V].reshape(b, s, N_MLSTM_HEADS, HEAD_DIM)
    v = p[..., OFF_V:OFF_O].reshape(b, s, N_MLSTM_HEADS, HEAD_DIM)
    o = p[..., OFF_O:OFF_I]
    i_pre = p[..., OFF_I:OFF_F]
    f_pre = p[..., OFF_F:OFF_B]
    h = mlstm_cell(q, k, v, i_pre, f_pre)
    mu = h.mean(-1, keepdims=True)
    var = jnp.square(h - mu).mean(-1, keepdims=True)
    h = (h - mu) * lax.rsqrt(var + LN_EPS) * mh_g.astype(jnp.float32).reshape(N_MLSTM_HEADS, HEAD_DIM)
    y_m = (jax.nn.sigmoid(o.astype(jnp.float32)) * h.reshape(b, s, D_MLSTM)).astype(x.dtype)

    gate_b = p[..., OFF_B:OFF_C]
    gate_c = p[..., OFF_C:OFF_X]
    xc = p[..., OFF_X:P_IN]
    u = gate_c * xc
    conv = lax.conv_general_dilated(u, conv_w[:, None, :].astype(u.dtype), window_strides=(1,),
                                    padding=[(CONV_WIDTH - 1, 0)], dimension_numbers=('NWC', 'WIO', 'NWC'),
                                    feature_group_count=D_CONV)
    y_c = gate_b * conv
    return jnp.concatenate([y_m, y_c], axis=-1) @ w_out


def grouped_moe(x, router_w, router_b, w_gate, w_up, w_down):
    b, s, d = x.shape
    n = b * s
    xf = x.reshape(n, d)
    probs = jax.nn.softmax((xf @ router_w).astype(jnp.float32) + router_b.astype(jnp.float32), axis=-1)
    pg = probs.reshape(n, N_GROUPS, EXPERTS_PER_GROUP)
    grp = jnp.argmax(lax.top_k(pg, TOP_K)[0].sum(-1), axis=-1)
    in_grp = jnp.take_along_axis(pg, grp[:, None, None], axis=1)[:, 0]
    top_p, top_local = lax.top_k(in_grp, TOP_K)
    expert_idx = grp[:, None] * EXPERTS_PER_GROUP + top_local
    gates = top_p / top_p.sum(-1, keepdims=True)

    flat_e = expert_idx.reshape(-1)
    order = jnp.argsort(flat_e)
    e_sorted = flat_e[order]
    tok_sorted = order // TOP_K
    gate_sorted = gates.reshape(-1)[order]
    counts = jnp.bincount(flat_e, length=N_EXPERTS)
    padded = (counts + EXPERT_BLOCK - 1) // EXPERT_BLOCK * EXPERT_BLOCK
    pad_end = jnp.cumsum(padded)
    pad_start = pad_end - padded
    start = jnp.cumsum(counts) - counts
    dest = pad_start[e_sorted] + (jnp.arange(n * TOP_K) - start[e_sorted])
    n_blocks = (n * TOP_K + EXPERT_BLOCK - 1) // EXPERT_BLOCK + N_EXPERTS
    buf = jnp.zeros((n_blocks * EXPERT_BLOCK, d), x.dtype).at[dest].set(xf[tok_sorted])
    block_expert = jnp.minimum(
        jnp.searchsorted(pad_end, jnp.arange(n_blocks) * EXPERT_BLOCK, side='right'), N_EXPERTS - 1)

    def expert_block(args):
        xb, e = args
        hdn = jax.nn.silu(xb @ w_gate[e]) * (xb @ w_up[e])
        return hdn @ w_down[e]

    y_buf = lax.map(expert_block, (buf.reshape(n_blocks, EXPERT_BLOCK, d), block_expert)).reshape(-1, d)
    y = y_buf[dest] * gate_sorted[:, None].astype(x.dtype)
    return jnp.zeros_like(xf).at[tok_sorted].add(y).reshape(b, s, d)


def setup_inputs(seed: int = 0) -> dict:
    key = jax.random.key(seed)
    ks = jax.random.split(key, 16)
    f32 = jnp.float32
    x = jax.random.normal(ks[0], (BATCH, SEQ, D_MODEL), f32)
    col_scale = jnp.ones((P_IN,), f32).at[OFF_V:OFF_O].set(BETA).at[OFF_X:P_IN].set(BETA)
    w_in = jax.random.normal(ks[1], (DEPTH, D_MODEL, P_IN), f32) * (D_MODEL ** -0.5) * col_scale
    b_in = (0.02 * jax.random.normal(ks[2], (DEPTH, P_IN), f32)).at[:, OFF_F:OFF_B].add(
        jnp.linspace(3.0, 6.0, N_MLSTM_HEADS, dtype=f32))
    conv_w = jax.random.normal(ks[3], (DEPTH, CONV_WIDTH, D_CONV), f32) * (CONV_WIDTH ** -0.5)
    mh_norm_g = 1.0 + 0.02 * jax.random.normal(ks[4], (DEPTH, D_MLSTM), f32)
    w_out = jax.random.normal(ks[5], (DEPTH, D_MIX, D_MODEL), f32) * (D_MIX ** -0.5) * BETA
    ln_mix_g = 1.0 + 0.02 * jax.random.normal(ks[6], (DEPTH, D_MODEL), f32)
    ln_mix_b = 0.02 * jax.random.normal(ks[7], (DEPTH, D_MODEL), f32)
    router_w = jax.random.normal(ks[8], (D_MODEL, N_EXPERTS), f32) * (D_MODEL ** -0.5)
    router_b = 0.01 * jax.random.normal(ks[9], (N_EXPERTS,), f32)
    w_gate = jax.random.normal(ks[10], (DEPTH, N_EXPERTS, D_MODEL, D_FF_EXPERT), f32) * (D_MODEL ** -0.5)
    w_up = jax.random.normal(ks[11], (DEPTH, N_EXPERTS, D_MODEL, D_FF_EXPERT), f32) * (D_MODEL ** -0.5)
    w_down = jax.random.normal(ks[12], (DEPTH, N_EXPERTS, D_FF_EXPERT, D_MODEL), f32) * (D_FF_EXPERT ** -0.5) * BETA
    ln_moe_g = 1.0 + 0.02 * jax.random.normal(ks[13], (DEPTH, D_MODEL), f32)
    ln_moe_b = 0.02 * jax.random.normal(ks[14], (DEPTH, D_MODEL), f32)
    return {"x": x, "w_in": w_in, "b_in": b_in, "conv_w": conv_w, "mh_norm_g": mh_norm_g, "w_out": w_out,
            "ln_mix_g": ln_mix_g, "ln_mix_b": ln_mix_b, "router_w": router_w, "router_b": router_b,
            "w_gate": w_gate, "w_up": w_up, "w_down": w_down, "ln_moe_g": ln_moe_g, "ln_moe_b": ln_moe_b}


def reference(x, w_in, b_in, conv_w, mh_norm_g, w_out, ln_mix_g, ln_mix_b, router_w, router_b,
              w_gate, w_up, w_down, ln_moe_g, ln_moe_b):
    for l in range(DEPTH):
        mix = hybrid_mixer(x, w_in[l], b_in[l], conv_w[l], mh_norm_g[l], w_out[l])
        x = layer_norm(ALPHA * x + mix, ln_mix_g[l], ln_mix_b[l])
        ffn = grouped_moe(x, router_w, router_b, w_gate[l], w_up[l], w_down[l])
        x = layer_norm(ALPHA * x + ffn, ln_moe_g[l], ln_moe_b[l])
    return x
```

```cpp
#include <hip/hip_runtime.h>
#include <cstdio>
#include <cstdint>

#ifndef MK_PER_PHASE
#define MK_PER_PHASE 0
#endif
#ifndef PH_MASK
#define PH_MASK 0x3ff
#endif
#define EN(k) (((PH_MASK) >> (k)) & 1)
#ifndef REP_MASK
#define REP_MASK 0
#endif
#define REPS(k) (1 + (((REP_MASK) >> (k)) & 1))

#define LAS __attribute__((address_space(3)))
#define GAS __attribute__((address_space(1)))
typedef unsigned short bf16_t;
typedef short bf16x8 __attribute__((ext_vector_type(8)));
typedef float f32x4 __attribute__((ext_vector_type(4)));
typedef float f32x2 __attribute__((ext_vector_type(2)));
typedef int i32x8v __attribute__((ext_vector_type(8)));
typedef float f32x8v __attribute__((ext_vector_type(8)));
typedef unsigned u32x4 __attribute__((ext_vector_type(4)));
typedef unsigned u32x2 __attribute__((ext_vector_type(2)));
#define RLX_AGENT __ATOMIC_RELAXED, __HIP_MEMORY_SCOPE_AGENT
#define LDS_WAIT() asm volatile("s_waitcnt lgkmcnt(0)" ::: "memory")
#define VM_WAIT() asm volatile("s_waitcnt vmcnt(0)" ::: "memory")

constexpr int D = 1024, NB = 8, SEQ = 8192, M = NB * SEQ, DEPTH = 4;
constexpr int NH = 4, DH = 128, CHK = 128, NCH = SEQ / CHK;
constexpr int PIN = 3592;
constexpr int NP = 3584;
constexpr int NPB = 1024;
constexpr int PQ = 0, PK = 512;
constexpr int NCV = 3072;
constexpr int CGB = 0, CU = 512, CO = 1024, CVV = 1536, CQ = 2048, CK = 2560;
__host__ __device__ __forceinline__ int win_src_col(int n) {
    const int grp = n >> 9;
    if (grp >= 5) { const int w = n & 255, t = (n - 2560) >> 8; return (((w >> 5) & 1) ? 3080 : 2568) + t * 128 + (w >> 6) * 32 + (w & 31); }
    return (grp == 0 ? 0 : grp == 1 ? 2056 : grp == 2 ? 512 : grp == 3 ? 1024 : 1536) + (n & 511);
}
constexpr int SRC_IF = 2048;
constexpr int NE = 16, DFF = 512;
constexpr int MAXROWS = 2 * M + NE * 256;
constexpr float ALPHA = 1.6817928305074290f, LN_EPS = 1e-5f;
constexpr float YB_SCALE = 8.0f;
constexpr int NWAVES = 8, NTHR = 512;
constexpr int NPHASE = 1 + DEPTH * 9;

constexpr size_t MiB = (size_t)1 << 20;
constexpr size_t WS_CTL = 0, CTL_ZERO_BYTES = MK_PER_PHASE ? 2 * MiB : 32768;
constexpr size_t WS_RFB = 2 * MiB;
constexpr size_t WS_WIFP = 2 * MiB + 65536;
constexpr size_t WS_GATES = 3 * MiB;
constexpr size_t WS_AA = 5 * MiB;
constexpr size_t WS_BB = 6 * MiB;
constexpr size_t WS_NL = 7 * MiB;
constexpr size_t WS_ML = 8 * MiB;
constexpr size_t WS_GC = 8 * MiB + 8192;
constexpr size_t WS_MST = 8 * MiB + 16384;
constexpr size_t WS_RE = 9 * MiB;
constexpr size_t WS_RS = 9 * MiB + 512 * 1024;
constexpr size_t WS_NST = 10 * MiB;
constexpr size_t WS_TLIST = 11 * MiB;
constexpr size_t WS_GLIST = 15 * MiB;
constexpr size_t WS_PM = 19 * MiB;
constexpr size_t WS_WIN = 20 * MiB;
constexpr size_t WS_WOUT = 48 * MiB;
constexpr size_t WS_WGU = 56 * MiB;
constexpr size_t WS_WDN = 184 * MiB;
constexpr size_t WS_X = 248 * MiB;
constexpr size_t WS_CS = 376 * MiB;
constexpr size_t WS_PRE = WS_CS;
constexpr size_t WS_P = 504 * MiB;
constexpr size_t WS_CV = 504 * MiB + 128 * MiB;
constexpr size_t WS_XF = WS_P;
constexpr size_t WS_HDN = WS_P;
constexpr size_t WS_YB = 640 * MiB;
constexpr size_t WS_END = 952 * MiB;
constexpr size_t X1F_OFF = 160 * MiB;
constexpr size_t CSB_OFF = 128 * MiB;
static_assert(WS_CV + (size_t)M * NCV <= WS_END, "ws map: CV");
static_assert(WS_HDN + (size_t)MAXROWS * DFF * 2 <= WS_YB && WS_YB + (size_t)MAXROWS * D * 2 <= WS_END && WS_P + (size_t)M * NP * 2 <= WS_END, "ws map");
constexpr int CW_CNT = 64;
constexpr int CW_LEFT = 1024;
constexpr int CW_BAR = 4096;
constexpr int SCR_BYTES = 131072;
constexpr int MISC_OFF = SCR_BYTES;
constexpr int TOK_OFF = MISC_OFF + 1024, MAXU = 12;
constexpr int BIAS_OFF = 147456;
constexpr int LDS_BYTES = 163840;
static_assert(TOK_OFF + MAXU * 256 * 4 <= BIAS_OFF && BIAS_OFF + NP * 4 <= LDS_BYTES, "lds map");

__device__ __forceinline__ int opaque_tid() { int t = threadIdx.x; asm volatile("" : "+v"(t)); return t; }
__device__ __forceinline__ float bf2f(unsigned b) { return __uint_as_float(b << 16); }
__device__ __forceinline__ unsigned pk2(float lo, float hi) { unsigned r; asm volatile("v_cvt_pk_bf16_f32 %0, %1, %2" : "=v"(r) : "v"(lo), "v"(hi)); return r; }
__device__ __forceinline__ unsigned pack4_fp8c(const f32x4 v, float scale) {
    const f32x4 sv = v * scale;
    const float a = __builtin_amdgcn_fmed3f(sv[0], -400.f, 400.f), b = __builtin_amdgcn_fmed3f(sv[1], -400.f, 400.f), c = __builtin_amdgcn_fmed3f(sv[2], -400.f, 400.f), d = __builtin_amdgcn_fmed3f(sv[3], -400.f, 400.f);
    int w = __builtin_amdgcn_cvt_pk_fp8_f32(a, b, 0, false); w = __builtin_amdgcn_cvt_pk_fp8_f32(c, d, w, true); return (unsigned)w; }
__device__ __forceinline__ f32x4 unpack4_fp8(unsigned w) { const f32x2 lo = __builtin_amdgcn_cvt_pk_f32_fp8((int)w, false), hi = __builtin_amdgcn_cvt_pk_f32_fp8((int)w, true); return (f32x4){lo[0], lo[1], hi[0], hi[1]}; }
__device__ __forceinline__ u32x4 fp8x8_to_bf16x8(const u32x2 w) { const f32x4 a = unpack4_fp8(w.x), b = unpack4_fp8(w.y); u32x4 o; o.x = pk2(a[0], a[1]); o.y = pk2(a[2], a[3]); o.z = pk2(b[0], b[1]); o.w = pk2(b[2], b[3]); return o; }
__device__ __forceinline__ u32x4 widen_fp8_pair(const u32x2 a, const u32x2 b) {
    const auto r0 = __builtin_amdgcn_permlane16_swap(a.x, b.x, false, false); const auto r1 = __builtin_amdgcn_permlane16_swap(a.y, b.y, false, false);
    u32x4 w; w.x = r0[0]; w.y = r1[0]; w.z = r0[1]; w.w = r1[1]; return w; }
__device__ __forceinline__ void lane_row_transpose4(unsigned (&x)[4]) {
    const auto a = __builtin_amdgcn_permlane16_swap(x[0], x[1], false, false), b = __builtin_amdgcn_permlane16_swap(x[2], x[3], false, false);
    const auto c = __builtin_amdgcn_permlane32_swap(a[0], b[0], false, false), d = __builtin_amdgcn_permlane32_swap(a[1], b[1], false, false);
    x[0] = c[0]; x[1] = d[0]; x[2] = c[1]; x[3] = d[1];
}
constexpr float WGU_SCALE = 32.0f, WDN_SCALE = 64.0f, H_SCALE = 4.0f, WOUT_SCALE = 64.0f, Y_SCALE = 8.0f, WIN_SCALE = 32.0f;
constexpr float CL_SCALE = 16.0f, CS_SCALE = 8.0f;
#define MFMA_DRAIN() do { __builtin_amdgcn_sched_barrier(0); asm volatile("s_nop 15\n\ts_nop 15" ::: "memory"); __builtin_amdgcn_sched_barrier(0); } while (0)
__device__ __forceinline__ void unpack8(const u32x4 w, float (&f)[8]) {
    f[0] = __uint_as_float(w.x << 16); f[1] = __uint_as_float(w.x & 0xffff0000u); f[2] = __uint_as_float(w.y << 16); f[3] = __uint_as_float(w.y & 0xffff0000u);
    f[4] = __uint_as_float(w.z << 16); f[5] = __uint_as_float(w.z & 0xffff0000u); f[6] = __uint_as_float(w.w << 16); f[7] = __uint_as_float(w.w & 0xffff0000u);
}
__device__ __forceinline__ u32x4 pack8(const float (&f)[8]) { u32x4 w; w.x = pk2(f[0], f[1]); w.y = pk2(f[2], f[3]); w.z = pk2(f[4], f[5]); w.w = pk2(f[6], f[7]); return w; }
__device__ __forceinline__ float shx(float v, int mask, int lane) { return __int_as_float(__builtin_amdgcn_ds_bpermute((lane ^ mask) << 2, __float_as_int(v))); }
__device__ __forceinline__ float shup(float v, int d, int lane) { return __int_as_float(__builtin_amdgcn_ds_bpermute((lane - d) << 2, __float_as_int(v))); }
__device__ __forceinline__ float rdlane(float v, int src) { return __int_as_float(__builtin_amdgcn_readlane(__float_as_int(v), src)); }
template <int CTRL> __device__ __forceinline__ float dpp_mov(float v) { return __int_as_float(__builtin_amdgcn_update_dpp(0, __float_as_int(v), CTRL, 0xF, 0xF, true)); }
__device__ __forceinline__ float row_sum16(float v) { v += dpp_mov<0xB1>(v); v += dpp_mov<0x4E>(v); v += dpp_mov<0x141>(v); v += dpp_mov<0x140>(v); return v; }
__device__ __forceinline__ float wave_sum(float v, int) { v = row_sum16(v); return (rdlane(v, 0) + rdlane(v, 16)) + (rdlane(v, 32) + rdlane(v, 48)); }
__device__ __forceinline__ float sum_rows4(float v) {
    const auto a = __builtin_amdgcn_permlane32_swap(__float_as_uint(v), __float_as_uint(v), false, false); v = __uint_as_float(a[0]) + __uint_as_float(a[1]);
    const auto b = __builtin_amdgcn_permlane16_swap(__float_as_uint(v), __float_as_uint(v), false, false); return __uint_as_float(b[0]) + __uint_as_float(b[1]);
}
__device__ __forceinline__ float wave_max(float v, int lane) {
#pragma unroll
    for (int o = 1; o < 64; o <<= 1) v = fmaxf(v, shx(v, o, lane));
    return v;
}
__device__ __forceinline__ float sigmoidf_(float x) { return __builtin_amdgcn_rcpf(1.0f + __expf(-x)); }

#define XB_TMO      128
#define XB_XCNT(j)  (256  + 64 * (j))
#define XB_XSUB(j)  (1280 + 64 * (j))
#define XB_XGEN(j)  (2304 + 64 * (j))
#define XB_TOP      3328
#define XB_TOPGEN   3392
#define XCD_BAR_WORDS 3456
#define XB_SPIN_CAP (1u << 18)
static_assert(MK_PER_PHASE || (size_t)(CW_BAR + XCD_BAR_WORDS) * 4 <= CTL_ZERO_BYTES, "control words");
__device__ __forceinline__ unsigned xb_ld(unsigned* p)              { return __hip_atomic_load(p, __ATOMIC_RELAXED, __HIP_MEMORY_SCOPE_AGENT); }
__device__ __forceinline__ unsigned xb_add(unsigned* p, unsigned v) { return __hip_atomic_fetch_add(p, v, __ATOMIC_RELAXED, __HIP_MEMORY_SCOPE_AGENT); }
__device__ __forceinline__ unsigned xb_xcc_id() { return (unsigned)__builtin_amdgcn_s_getreg((3 << 11) | 20) & 0xFu; }
#define XB_SPIN(cond, bar) do { unsigned _sp = 0; while (cond) { __builtin_amdgcn_s_sleep(1); \
    if ((++_sp & 255u) == 0u) { if (xb_ld(&(bar)[XB_TMO])) break; if (_sp > XB_SPIN_CAP) { atomicAdd(&(bar)[XB_TMO], 1u); break; } } } } while (0)
struct XcdBarrier { unsigned* bar; unsigned x; volatile LAS unsigned* st; };
__device__ __forceinline__ XcdBarrier xcd_barrier_post(unsigned* bar, volatile LAS unsigned* st) {
    XcdBarrier b; b.bar = bar; b.x = xb_xcc_id(); b.st = st;
    if (threadIdx.x == 0) (void)xb_add(&bar[XB_XCNT(b.x)], 1u);
    return b;
}
__device__ __forceinline__ void xcd_barrier_complete(unsigned* bar, unsigned x, unsigned& nloc, unsigned& nx) {
    const unsigned G = gridDim.x * gridDim.y * gridDim.z;
    unsigned sum, cnt, mine, sp = 0u;
    for (;;) {
        sum = 0u; cnt = 0u; mine = 0u;
#pragma unroll
        for (unsigned j = 0; j < 16; ++j) { const unsigned c = xb_ld(&bar[XB_XCNT(j)]); sum += c; cnt += (c > 0u) ? 1u : 0u; mine = (j == x) ? c : mine; }
        if (sum == G) break;
        __builtin_amdgcn_s_sleep(1);
        if ((++sp & 255u) == 0u) { if (xb_ld(&bar[XB_TMO])) break; if (sp > XB_SPIN_CAP) { atomicAdd(&bar[XB_TMO], 1u); break; } }
    }
    nloc = mine > 0u ? mine : 1u; nx = cnt > 0u ? cnt : 1u;
}
__device__ __forceinline__ void xcd_barrier(const XcdBarrier& b) {
    asm volatile("s_waitcnt vmcnt(0)" ::: "memory");
    __syncthreads();
    if (threadIdx.x == 0) {
        unsigned* bar = b.bar;
        __builtin_amdgcn_s_waitcnt(0);
        unsigned nloc = b.st[0], nx = b.st[1];
        if (nloc == 0u) { xcd_barrier_complete(bar, b.x, nloc, nx); b.st[0] = nloc; b.st[1] = nx; }
        const unsigned old = xb_add(&bar[XB_XSUB(b.x)], 1u);
        const unsigned gen = old / nloc;
        if (old + 1u == (gen + 1u) * nloc) {
            __builtin_amdgcn_fence(__ATOMIC_RELEASE, "agent");
            asm volatile("s_waitcnt vmcnt(0)" ::: "memory");
            const unsigned og = xb_add(&bar[XB_TOP], 1u);
            const unsigned tg = og / nx;
            if (og + 1u == (tg + 1u) * nx) xb_add(&bar[XB_TOPGEN], 1u);
            else XB_SPIN(xb_ld(&bar[XB_TOPGEN]) == tg, bar);
            __builtin_amdgcn_fence(__ATOMIC_ACQUIRE, "agent");
            xb_add(&bar[XB_XGEN(b.x)], 1u);
            asm volatile("s_waitcnt vmcnt(0)" ::: "memory");
        } else {
            XB_SPIN(xb_ld(&bar[XB_XGEN(b.x)]) == gen, bar);
            __builtin_amdgcn_fence(__ATOMIC_ACQUIRE, "agent");
            asm volatile("s_waitcnt vmcnt(0)" ::: "memory");
        }
    }
    __syncthreads();
}

namespace pg8 {
constexpr int BM = 256, BK = 64, HALF = 128, HTB = HALF * BK * 2, STAGE_BYTES = 8 * HTB, NXCD = 8, WGM = 4;
__host__ __device__ __forceinline__ int lds_byte(int r, int c) { const int st = (r >> 4) * 2 + (c >> 5), rr = r & 15, cc = c & 31, ob = rr * 64 + cc * 2; return st * 1024 + (ob ^ (((ob >> 9) & 1) << 5)); }
__host__ __device__ __forceinline__ void stage_rc(int b, int& R, int& C) { const int st = b / 1024, sb = b % 1024, swz = sb ^ (((sb >> 9) & 1) << 5); R = (st >> 1) * 16 + swz / 64; C = (st & 1) * 32 + (swz % 64) / 2; }
__host__ __device__ __forceinline__ int perm32(int rho) { const int n = rho >> 4, i = rho & 15; return 8 * (i >> 2) + 4 * n + (i & 3); }

struct Unit { int pm, pn, e, rb, ui; };

__device__ __forceinline__ void static_unit(int nM, int nN, int wgid0, Unit& u, int rot = 0) {
    const int nwg = nM * nN; int wgid = wgid0;
    { const int q = nwg / NXCD, r = nwg % NXCD, xcd = wgid % NXCD; int off = wgid / NXCD; const int qs = q + (xcd < r ? 1 : 0);
      if (rot) { off += rot; off -= (off >= qs) ? qs : 0; }
      wgid = (xcd < r ? xcd * (q + 1) : r * (q + 1) + (xcd - r) * q) + off; }
    const int nig = WGM * nN, gid = wgid / nig, fm = gid * WGM, gsz = (nM - fm) < WGM ? (nM - fm) : WGM;
    u.pm = fm + ((wgid % nig) % gsz); u.pn = (wgid % nig) / gsz; u.e = 0; u.rb = 0;
}
struct DenseOrder {
    static constexpr bool DENSE_A = true;
    int nM, nN, nwg, G, c, lda, K; const bf16_t* Bt;
    __device__ __forceinline__ bool next(int i, Unit& u) const { const long L = (long)i * G + c; if (L >= nwg) return false; static_unit(nM, nN, (int)L, u); u.ui = i; return true; }
    __device__ __forceinline__ void a_offsets(const Unit& u, int, unsigned (&off)[2][2]) const {
        const int tid = opaque_tid();
#pragma unroll
        for (int i = 0; i < 2; ++i) { int R, C; stage_rc(tid * 16 + i * 8192, R, C);
#pragma unroll
            for (int h = 0; h < 2; ++h) off[h][i] = (unsigned)((u.pm * BM + h * HALF + R) * lda + C) * 2u; }
    }
    __device__ __forceinline__ const char* b_tile(const Unit& u) const { return (const char*)(Bt + (size_t)u.pn * BM * K); }
};
constexpr int MOE_ROT = 16;
template <bool GATHER> struct MoeOrder {
    static constexpr bool DENSE_A = !GATHER;
    int nM, nN, nwg, G, c, lda, K; const bf16_t* Bt  ; size_t estride; LAS const int* tab; LAS const int* toks;
    int i0, ni, L; LAS const unsigned* lmask; unsigned* left;
    __device__ __forceinline__ bool next(int i, Unit& u) const {
        int id;
        if (GATHER) { if (i >= ni) return false; id = (i + i0) * G + c; if (id >= nwg) return false; static_unit(nM, nN, id, u); }
        else { const int v = (i + (c < L ? 2 : 0)) * G + c; const int mn = (v < G ? v : v - G) < L ? (v < G ? v : v - G) : L; const int resv = v < G ? mn : v < 2 * G ? L + mn : 2 * L;
               id = v - resv; if (id >= nwg) return false; static_unit(nM, nN, id, u, MOE_ROT); }
        u.ui = i;
        int e = 0;
#pragma unroll
        for (int q = 1; q < 16; ++q) e += (u.pm >= tab[16 + q]) ? 1 : 0;
        e = __builtin_amdgcn_readfirstlane(e); u.e = e; u.rb = __builtin_amdgcn_readfirstlane(u.pm - tab[16 + e]); return true;
    }
    __device__ __forceinline__ void a_offsets(const Unit& u, int ui, unsigned (&off)[2][2]) const {
        const int tid = opaque_tid();
        if (!GATHER) { if ((lmask[u.pm >> 5] >> (u.pm & 31)) & 1u) {
            unsigned sp = 0; while (xb_ld(left) < (unsigned)L && ++sp < XB_SPIN_CAP) __builtin_amdgcn_s_sleep(1);
            __builtin_amdgcn_fence(__ATOMIC_ACQUIRE, "agent"); } }
#pragma unroll
        for (int i = 0; i < 2; ++i) { int R, C; stage_rc(tid * 16 + i * 8192, R, C);
#pragma unroll
            for (int h = 0; h < 2; ++h) {
                if (GATHER) off[h][i] = (unsigned)(toks[ui * 256 + h * HALF + R] * lda + C) * 2u;
                else off[h][i] = (unsigned)((u.pm * BM + h * HALF + R) * lda + C) * 2u; } }
    }
    __device__ __forceinline__ const char* b_tile(const Unit& u) const { return (const char*)(Bt + (size_t)u.e * estride + (size_t)u.pn * BM * K); }
};

__device__ __forceinline__ unsigned cvt_pk_bf16(float lo, float hi) { unsigned r; asm volatile("v_cvt_pk_bf16_f32 %0, %1, %2" : "=v"(r) : "v"(lo), "v"(hi)); return r; }

struct EpiInProj {
    static constexpr bool PEEL = true; static constexpr bool FP8 = true; static constexpr bool PERM = true; static constexpr int NVM = 8;
    bf16_t* O; unsigned char* O8; LAS const float* bias_lds;
    __device__ __forceinline__ void operator()(f32x4 (&acc)[2][2][4][2], const Unit& u, int wr, int wc, int fr, int fq) const {
        const int row0 = u.pm * BM + wr * 64 + fr, cl = wc * 64 + 8 * fq, grp = u.pn >> 1, hc = (u.pn & 1) * BM + cl;
        LAS const float* bias = bias_lds + u.pn * BM;
#pragma unroll
        for (int bj = 0; bj < 2; ++bj)
#pragma unroll
            for (int n = 0; n < 2; ++n) { const f32x4 bv = *(LAS const f32x4*)(bias + cl + bj * 32 + 4 * n);
#pragma unroll
                for (int ai = 0; ai < 2; ++ai)
#pragma unroll
                    for (int m = 0; m < 4; ++m) acc[ai][bj][m][n] = acc[ai][bj][m][n] * (1.0f / WIN_SCALE) + bv; }
        if (grp >= 5) {
            const int c8 = CU + (u.pn - 10) * HALF + wc * 32 + 8 * fq;
#pragma unroll
            for (int ai = 0; ai < 2; ++ai)
#pragma unroll
                for (int m = 0; m < 4; ++m) { u32x2 a; a.x = pack4_fp8c(acc[ai][0][m][0] * acc[ai][1][m][0], 1.0f); a.y = pack4_fp8c(acc[ai][0][m][1] * acc[ai][1][m][1], 1.0f);
                    *(u32x2*)(O8 + (size_t)(row0 + ai * HALF + m * 16) * NCV + c8) = a; }
        } else {
            const int c8 = (grp == 0 ? CQ : grp == 1 ? CGB : grp == 2 ? CK : grp == 3 ? CVV : CO) + hc;
#pragma unroll
            for (int ai = 0; ai < 2; ++ai)
#pragma unroll
                for (int m = 0; m < 4; ++m) { unsigned char* rowp = O8 + (size_t)(row0 + ai * HALF + m * 16) * NCV + (c8 - 8 * fq) + (fq & 1) * 32 + 8 * (fq & ~1);
                    u32x2 a, b; a.x = pack4_fp8c(acc[ai][0][m][0], 1.0f); a.y = pack4_fp8c(acc[ai][0][m][1], 1.0f); b.x = pack4_fp8c(acc[ai][1][m][0], 1.0f); b.y = pack4_fp8c(acc[ai][1][m][1], 1.0f);
                    *(u32x4*)rowp = widen_fp8_pair(a, b); }
        }
    }
};
struct EpiOutProj {
    static constexpr bool PEEL = true; static constexpr bool FP8 = true; static constexpr bool PERM = true; static constexpr int NVM = 16;
    bf16_t* O; const bf16_t* X;
    __device__ __forceinline__ void operator()(const f32x4 (&acc)[2][2][4][2], const Unit& u, int wr, int wc, int fr, int fq) const {
        const int row0 = u.pm * BM + wr * 64 + fr, col0 = u.pn * BM + wc * 64 + 8 * fq;
        constexpr float IS = 1.0f / (Y_SCALE * WOUT_SCALE);
        u32x4 xr[2][4][2];
#pragma unroll
        for (int ai = 0; ai < 2; ++ai)
#pragma unroll
            for (int m = 0; m < 4; ++m)
#pragma unroll
                for (int bj = 0; bj < 2; ++bj) xr[ai][m][bj] = *(const u32x4*)(X + (size_t)(row0 + ai * HALF + m * 16) * D + col0 + bj * 32);
#pragma unroll
        for (int ai = 0; ai < 2; ++ai)
#pragma unroll
            for (int m = 0; m < 4; ++m)
#pragma unroll
                for (int bj = 0; bj < 2; ++bj) asm volatile("" : "+v"(xr[ai][m][bj]));
#pragma unroll
        for (int ai = 0; ai < 2; ++ai)
#pragma unroll
            for (int m = 0; m < 4; ++m) { const size_t off = (size_t)(row0 + ai * HALF + m * 16) * D + col0;
#pragma unroll
                for (int bj = 0; bj < 2; ++bj) { float xf[8]; unpack8(xr[ai][m][bj], xf);
                    const f32x4 a0 = acc[ai][bj][m][0], a1 = acc[ai][bj][m][1];
                    u32x4 w; w.x = cvt_pk_bf16(a0[0] * IS + ALPHA * xf[0], a0[1] * IS + ALPHA * xf[1]); w.y = cvt_pk_bf16(a0[2] * IS + ALPHA * xf[2], a0[3] * IS + ALPHA * xf[3]);
                    w.z = cvt_pk_bf16(a1[0] * IS + ALPHA * xf[4], a1[1] * IS + ALPHA * xf[5]); w.w = cvt_pk_bf16(a1[2] * IS + ALPHA * xf[6], a1[3] * IS + ALPHA * xf[7]);
                    *(u32x4*)(O + off + bj * 32) = w; } }
    }
};
struct EpiGateUp {
    static constexpr bool PEEL = true; static constexpr bool FP8 = true; static constexpr bool PERM = true; static constexpr int NVM = 8;
    unsigned char* O;
    __device__ __forceinline__ void operator()(const f32x4 (&acc)[2][2][4][2], const Unit& u, int wr, int wc, int fr, int fq) const {
        const int row0 = u.pm * BM + wr * 64 + fr, col0 = u.pn * HALF + wc * 32 + 8 * fq;
        constexpr float TS = -1.4426950408889634f / WGU_SCALE, HS = H_SCALE / (WGU_SCALE * WGU_SCALE);
#pragma unroll
        for (int ai = 0; ai < 2; ++ai)
#pragma unroll
            for (int m = 0; m < 4; ++m) { u32x2 hw;
#pragma unroll
                for (int n = 0; n < 2; ++n) { const f32x4 g = acc[ai][0][m][n], up = acc[ai][1][m][n];
                    const f32x4 t4 = g * TS; const f32x4 e4 = (f32x4){__builtin_amdgcn_exp2f(t4[0]), __builtin_amdgcn_exp2f(t4[1]), __builtin_amdgcn_exp2f(t4[2]), __builtin_amdgcn_exp2f(t4[3])} + 1.0f;
                    const f32x4 r4 = (f32x4){__builtin_amdgcn_rcpf(e4[0]), __builtin_amdgcn_rcpf(e4[1]), __builtin_amdgcn_rcpf(e4[2]), __builtin_amdgcn_rcpf(e4[3])};
                    const unsigned pw = pack4_fp8c((g * up) * r4, HS); if (n == 0) hw.x = pw; else hw.y = pw; }
                *(u32x2*)(O + (size_t)(row0 + ai * HALF + m * 16) * DFF + col0) = hw; }
    }
};
struct EpiDown {
    static constexpr bool PEEL = false; static constexpr bool FP8 = true; static constexpr bool PERM = true; static constexpr int NVM = 8;
    unsigned char* O; LAS const float* gates; LAS const int* dsts;
    __device__ __forceinline__ void operator()(const f32x4 (&acc)[2][2][4][2], const Unit& u, int wr, int wc, int fr, int fq) const {
        const int rl0 = wr * 64 + fr, col0 = u.pn * BM + wc * 64 + 8 * fq;
#pragma unroll
        for (int ai = 0; ai < 2; ++ai)
#pragma unroll
            for (int m = 0; m < 4; ++m) { const int rl = rl0 + ai * HALF + m * 16;
                const float g = gates[u.ui * 256 + rl] * (YB_SCALE / (H_SCALE * WDN_SCALE)); const int d = dsts[u.ui * 256 + rl];
                u32x2 a, b; a.x = pack4_fp8c(acc[ai][0][m][0], g); a.y = pack4_fp8c(acc[ai][0][m][1], g); b.x = pack4_fp8c(acc[ai][1][m][0], g); b.y = pack4_fp8c(acc[ai][1][m][1], g);
                const u32x4 w = widen_fp8_pair(a, b);
                unsigned char* rowp = O + (unsigned)((d < 0 ? 2 * M : (d & 1) * M + (d >> 1)) * D + (col0 - 8 * fq) + (fq & 1) * 32 + 8 * (fq & ~1));
                *(u32x4*)rowp = w; }
    }
};

template <class Epi, class Sched, bool ALIGN = true>
__device__ __forceinline__ void gemm_phase(LAS unsigned char* lds, const bf16_t* Aptr, const Sched& S, const Epi& E) {
    const int tid = opaque_tid(), wid = __builtin_amdgcn_readfirstlane(tid >> 6), lane = tid & 63, wr = wid >> 2, wc = wid & 3, fr = lane & 15, fq = lane >> 4;
    const int K = S.K, nt = K / BK;
    unsigned voffB[2];
#pragma unroll
    for (int i = 0; i < 2; ++i) { int R, C; stage_rc(tid * 16 + i * 8192, R, C); const int Rb = 64 * (R >> 5) + perm32(R & 31); voffB[i] = (unsigned)(Rb * K + C) * 2u; }
    const size_t kstep = (size_t)(BK * 2);
    const size_t hstep = (size_t)32 * K * 2;
    const unsigned ldsw = (unsigned)wid * 1024u;
    const int aoff = lds_byte(wr * 64 + fr, fq * 8), boff = lds_byte(wc * 32 + fr, fq * 8);
    const int aoff8 = lds_byte(wr * 64 + fr, (fq & 1) * 16) + (fq >> 1) * 1024, boff8 = lds_byte(wc * 32 + fr, (fq & 1) * 16) + (fq >> 1) * 1024;
    const char* Abase = (const char*)Aptr; const size_t ahalf = (size_t)HALF * S.lda * 2;
#define PG8_SA(b, h) (((b) * 2 + (h)) * HTB)
#define PG8_SB(b, h) ((4 + (b) * 2 + (h)) * HTB)
#define PG8_STAGE(bufoff, gbase, voff) do { _Pragma("unroll") for (int _i = 0; _i < 2; ++_i) \
        __builtin_amdgcn_global_load_lds((const unsigned*)((const char*)(gbase) + (voff)[_i]), (LAS unsigned*)(lds + (bufoff) + ldsw + _i * 8192), 16, 0, 0); } while (0)
#define PG8_STAGEA(bufoff, kb, off) PG8_STAGE(bufoff, Abase + (kb), off)
#define PG8_STAGEA1(bufoff, kb) do { if (Sched::DENSE_A) PG8_STAGE(bufoff, Abase + (kb) + ahalf, offC[0]); else PG8_STAGE(bufoff, Abase + (kb), offC[1]); } while (0)
typedef int i32x4v_ __attribute__((ext_vector_type(4)));
#define PG8_CAT8(x0_, x1_) __builtin_shufflevector(__builtin_bit_cast(i32x4v_, x0_), __builtin_bit_cast(i32x4v_, x1_), 0, 1, 2, 3, 4, 5, 6, 7)
#define PG8_LDA(dst, b, h) do { if (Epi::FP8) { _Pragma("unroll") for (int m = 0; m < 4; ++m) dst##8[m] = PG8_CAT8(*(const LAS bf16x8*)(lds + PG8_SA(b, h) + aoff8 + m * 2048), *(const LAS bf16x8*)(lds + PG8_SA(b, h) + aoff8 + m * 2048 + 16)); } \
        else { _Pragma("unroll") for (int m = 0; m < 4; ++m) _Pragma("unroll") for (int k = 0; k < 2; ++k) dst[m][k] = *(const LAS bf16x8*)(lds + PG8_SA(b, h) + aoff + m * 2048 + k * 1024); } } while (0)
#define PG8_LDB(dst, b, h) do { if (Epi::FP8) { _Pragma("unroll") for (int n = 0; n < 2; ++n) dst##8[n] = PG8_CAT8(*(const LAS bf16x8*)(lds + PG8_SB(b, h) + boff8 + n * 2048), *(const LAS bf16x8*)(lds + PG8_SB(b, h) + boff8 + n * 2048 + 16)); } \
        else { _Pragma("unroll") for (int n = 0; n < 2; ++n) _Pragma("unroll") for (int k = 0; k < 2; ++k) dst[n][k] = *(const LAS bf16x8*)(lds + PG8_SB(b, h) + boff + n * 2048 + k * 1024); } } while (0)
#define PG8_MMA(ai, bj, At, Bt) do { __builtin_amdgcn_s_setprio(1); \
        if (Epi::FP8) { _Pragma("unroll") for (int m = 0; m < 4; ++m) _Pragma("unroll") for (int n = 0; n < 2; ++n) \
                acc[ai][bj][m][n] = __builtin_amdgcn_mfma_scale_f32_16x16x128_f8f6f4(Bt##8[n], At##8[m], acc[ai][bj][m][n], 0, 0, 0, 0x7f7f7f7f, 0, 0x7f7f7f7f); \
              \
            _Pragma("unroll") for (int m = 0; m < 4; ++m) _Pragma("unroll") for (int n = 0; n < 2; ++n) asm volatile("" : "+v"(acc[ai][bj][m][n])); \
        } else { _Pragma("unroll") for (int m = 0; m < 4; ++m) _Pragma("unroll") for (int n = 0; n < 2; ++n) _Pragma("unroll") for (int k = 0; k < 2; ++k) \
            acc[ai][bj][m][n] = __builtin_amdgcn_mfma_f32_16x16x32_bf16(Bt[n][k], At[m][k], acc[ai][bj][m][n], 0, 0, 0); } \
        __builtin_amdgcn_s_setprio(0); } while (0)
#define PG8_WAIT_V(n) asm volatile("s_waitcnt vmcnt(" #n ")" ::: "memory")
#define PG8_WAIT_VN(a) asm volatile("s_waitcnt vmcnt(%0)" :: "n"(a) : "memory")
#define PG8_WAIT_L(n) asm volatile("s_waitcnt lgkmcnt(" #n ")" ::: "memory")
#define PG8_BAR __builtin_amdgcn_s_barrier()
#define PG8_SCHED __builtin_amdgcn_sched_barrier(0)
    Unit cur, nxt; int ui = 0;
    if (!S.next(0, cur)) return;
    f32x4 acc[2][2][4][2];
#pragma unroll
    for (int a = 0; a < 2; ++a)
#pragma unroll
        for (int b = 0; b < 2; ++b)
#pragma unroll
            for (int m = 0; m < 4; ++m)
#pragma unroll
                for (int n = 0; n < 2; ++n) acc[a][b][m][n] = (f32x4){0.f, 0.f, 0.f, 0.f};
    bf16x8 At[4][2], B0[2][2], B1[2][2]; i32x8v At8[4], B08[2], B18[2];
    unsigned offC[2][2];
    S.a_offsets(cur, 0, offC);
    const char* cB = S.b_tile(cur);
    PG8_STAGE(PG8_SB(0, 0), cB, voffB); PG8_STAGE(PG8_SB(0, 1), cB + hstep, voffB); PG8_STAGEA(PG8_SA(0, 0), 0, offC[0]); PG8_STAGEA1(PG8_SA(0, 1), 0);
    if (wr == 1) PG8_BAR;
    PG8_WAIT_V(2); PG8_BAR;
    PG8_STAGE(PG8_SB(1, 0), cB + kstep, voffB); PG8_STAGEA(PG8_SA(1, 0), kstep, offC[0]); PG8_STAGE(PG8_SB(1, 1), cB + hstep + kstep, voffB); if (Epi::PEEL) PG8_STAGEA1(PG8_SA(1, 1), kstep);
    PG8_WAIT_V(0); PG8_BAR;
    for (;;) {
        const bool has_next = S.next(ui + 1, nxt);
        const char* nB = has_next ? S.b_tile(nxt) : cB;
#define PG8_PAIR(t_, last_, WA, WB, WC, STG1) do { const int t = (t_); const bool last = (last_); \
            const size_t k1 = (size_t)(t + 1) * kstep; \
            const size_t k2 = last ? 0 : (size_t)(t + 2) * kstep, k3 = k2 + kstep; \
            const char* b2 = last ? nB : cB + (size_t)(t + 2) * kstep; const char* b3 = b2 + kstep; \
              \
            PG8_LDB(B0, 0, 0); PG8_LDB(B1, 0, 1); PG8_SCHED; PG8_LDA(At, 0, 0); if (STG1) PG8_STAGEA1(PG8_SA(1, 1), k1); \
            PG8_WAIT_VN(WA); PG8_WAIT_L(0); PG8_BAR; PG8_MMA(0, 0, At, B0); PG8_MMA(0, 1, At, B1); PG8_BAR; PG8_SCHED; \
            if (last && has_next) S.a_offsets(nxt, ui + 1, offC);        \
              \
            PG8_LDA(At, 0, 1); PG8_STAGE(PG8_SB(0, 0), b2, voffB); PG8_STAGE(PG8_SB(0, 1), b2 + hstep, voffB); PG8_STAGEA(PG8_SA(0, 0), k2, offC[0]); \
            PG8_WAIT_VN(WA); PG8_WAIT_L(0); PG8_BAR; PG8_MMA(1, 0, At, B0); PG8_MMA(1, 1, At, B1); PG8_BAR; PG8_SCHED; \
              \
            PG8_LDB(B0, 1, 0); PG8_LDB(B1, 1, 1); PG8_SCHED; PG8_LDA(At, 1, 0); PG8_STAGEA1(PG8_SA(0, 1), k2); \
            PG8_WAIT_VN(WB); PG8_WAIT_L(0); PG8_BAR; PG8_MMA(0, 0, At, B0); PG8_MMA(0, 1, At, B1); PG8_BAR; PG8_SCHED; \
              \
            PG8_LDA(At, 1, 1); PG8_STAGE(PG8_SB(1, 0), b3, voffB); PG8_STAGE(PG8_SB(1, 1), b3 + hstep, voffB); PG8_STAGEA(PG8_SA(1, 0), k3, offC[0]); \
            PG8_WAIT_VN(WC); PG8_WAIT_L(0); PG8_BAR; PG8_MMA(1, 0, At, B0); PG8_MMA(1, 1, At, B1); PG8_BAR; PG8_SCHED; } while (0)
        if (Epi::PEEL) { PG8_PAIR(0, false, 8 + Epi::NVM, 8 + Epi::NVM, 8, false);
            for (int tt = 2; tt < nt; tt += 2) PG8_PAIR(tt, tt == nt - 2, 8, 8, 8, true);
            if (has_next) PG8_STAGEA1(PG8_SA(1, 1), kstep); }
        else { for (int tt = 0; tt < nt; tt += 2) PG8_PAIR(tt, tt == nt - 2, 8, 8, 8, true); }
#undef PG8_PAIR
        if (ALIGN || !has_next) { if (wr == 0) PG8_BAR; }
        MFMA_DRAIN();
        { const int l2 = opaque_tid() & 63; E(acc, cur, wr, wc, l2 & 15, l2 >> 4); }
        PG8_SCHED;
        if (!has_next) break;
#pragma unroll
        for (int a = 0; a < 2; ++a)
#pragma unroll
            for (int b = 0; b < 2; ++b)
#pragma unroll
                for (int m = 0; m < 4; ++m)
#pragma unroll
                    for (int n = 0; n < 2; ++n) acc[a][b][m][n] = (f32x4){0.f, 0.f, 0.f, 0.f};
        cur = nxt; cB = nB; ++ui;
        if (ALIGN) { if (wr == 1) PG8_BAR; }
    }
    PG8_WAIT_V(0);
    PG8_BAR;
#undef PG8_SA
#undef PG8_SB
#undef PG8_STAGE
#undef PG8_STAGEA
#undef PG8_LDA
#undef PG8_LDB
#undef PG8_MMA
#undef PG8_WAIT_V
#undef PG8_WAIT_L
#undef PG8_BAR
#undef PG8_SCHED
}
}

struct Args { const float* in[15]; float* out; unsigned char* ws; int ph_lo, ph_hi, li, pad; };
struct Ctx {
    LAS unsigned char* lds; int tid, lane, wave, G, wg;
    const float *x, *w_in, *b_in, *conv_w, *mh_g, *w_out, *ln_mix_g, *ln_mix_b, *router_w, *router_b, *w_gate, *w_up, *w_down, *ln_moe_g, *ln_moe_b;
    float* out; unsigned char* ws;
};

__device__ __forceinline__ void load_row_bf16(const bf16_t* row, int lane, float (&v)[16]) {
    const u32x4 a = *(const u32x4*)(row + 8 * lane), b = *(const u32x4*)(row + 512 + 8 * lane);
    float t[8]; unpack8(a, t);
#pragma unroll
    for (int i = 0; i < 8; ++i) v[i] = t[i];
    unpack8(b, t);
#pragma unroll
    for (int i = 0; i < 8; ++i) v[8 + i] = t[i];
}
__device__ __forceinline__ void load_row_f32(const float* row, int lane, float (&v)[16]) {
#pragma unroll
    for (int j = 0; j < 2; ++j)
#pragma unroll
        for (int q = 0; q < 2; ++q) { const f32x4 a = *(const f32x4*)(row + 512 * j + 8 * lane + 4 * q);
            v[8 * j + 4 * q + 0] = a[0]; v[8 * j + 4 * q + 1] = a[1]; v[8 * j + 4 * q + 2] = a[2]; v[8 * j + 4 * q + 3] = a[3]; }
}
__device__ __forceinline__ void store_row_bf16(bf16_t* row, int lane, const float (&v)[16]) {
    u32x4 a, b; a.x = pk2(v[0], v[1]); a.y = pk2(v[2], v[3]); a.z = pk2(v[4], v[5]); a.w = pk2(v[6], v[7]);
    b.x = pk2(v[8], v[9]); b.y = pk2(v[10], v[11]); b.z = pk2(v[12], v[13]); b.w = pk2(v[14], v[15]);
    *(u32x4*)(row + 8 * lane) = a; *(u32x4*)(row + 512 + 8 * lane) = b;
}
__device__ __forceinline__ void store_row_f32(float* row, int lane, const float (&v)[16]) {
#pragma unroll
    for (int j = 0; j < 2; ++j)
#pragma unroll
        for (int q = 0; q < 2; ++q) *(f32x4*)(row + 512 * j + 8 * lane + 4 * q) = (f32x4){v[8 * j + 4 * q], v[8 * j + 4 * q + 1], v[8 * j + 4 * q + 2], v[8 * j + 4 * q + 3]};
}
__device__ __forceinline__ void ln_inplace(float (&v)[16], const float (&g)[16], const float (&b)[16], int lane) {
    float s = 0.f;
#pragma unroll
    for (int i = 0; i < 16; ++i) s += v[i];
    const float mean = wave_sum(s, lane) * (1.0f / D); float q = 0.f;
#pragma unroll
    for (int i = 0; i < 16; ++i) { v[i] -= mean; q += v[i] * v[i]; }
    const float rstd = __builtin_amdgcn_rsqf(wave_sum(q, lane) * (1.0f / D) + LN_EPS);
#pragma unroll
    for (int i = 0; i < 16; ++i) v[i] = v[i] * rstd * g[i] + b[i];
}
__device__ __forceinline__ int wperm_idx(int j, int k) { const int h = k >> 9, ln = (k & 511) >> 3, half = (k >> 2) & 1, i = k & 3; return ((j * 2 + h) * 2 + half) * 256 + ln * 4 + i; }
__device__ __forceinline__ void fill_wif(const Ctx& F, int l, LAS float* wif) {
    for (int k = F.tid; k < D; k += NTHR) { const float* src = F.w_in + ((size_t)l * D + k) * PIN + SRC_IF; const f32x4 a = *(const f32x4*)src, b = *(const f32x4*)(src + 4);
        wif[wperm_idx(0, k)] = a[0]; wif[wperm_idx(1, k)] = a[1]; wif[wperm_idx(2, k)] = a[2]; wif[wperm_idx(3, k)] = a[3];
        wif[wperm_idx(4, k)] = b[0]; wif[wperm_idx(5, k)] = b[1]; wif[wperm_idx(6, k)] = b[2]; wif[wperm_idx(7, k)] = b[3]; }
}
template <int NR, int NJ> __device__ __forceinline__ void row_dots(const float (&v)[NR][16], LAS const float* tab, int lane, float (&out)[NR * NJ]) {
#pragma unroll
    for (int j = 0; j < NJ; ++j) {
        float s[NR];
#pragma unroll
        for (int rr = 0; rr < NR; ++rr) s[rr] = 0.f;
#pragma unroll
        for (int hh = 0; hh < 4; ++hh) { const f32x4 w = *(LAS const f32x4*)(tab + (j * 4 + hh) * 256 + lane * 4);
#pragma unroll
            for (int rr = 0; rr < NR; ++rr) s[rr] += v[rr][4 * hh] * w[0] + v[rr][4 * hh + 1] * w[1] + v[rr][4 * hh + 2] * w[2] + v[rr][4 * hh + 3] * w[3]; }
#pragma unroll
        for (int rr = 0; rr < NR; ++rr) out[rr * NJ + j] = s[rr]; }
}
__device__ __forceinline__ int idx16(int lane) { return ((lane >> 5) & 1) * 8 + ((lane >> 4) & 1) * 4 + ((lane >> 3) & 1) * 2 + ((lane >> 2) & 1); }
__device__ __forceinline__ float reduce16(const float (&x)[16], int lane) {
    const bool b3 = (lane & 8) != 0, b2 = (lane & 4) != 0;
    float y[8], z[4], u[2];
#pragma unroll
    for (int i = 0; i < 8; ++i) { const auto r = __builtin_amdgcn_permlane32_swap(__float_as_uint(x[i]), __float_as_uint(x[8 + i]), false, false); y[i] = __uint_as_float(r[0]) + __uint_as_float(r[1]); }
#pragma unroll
    for (int i = 0; i < 4; ++i) { const auto r = __builtin_amdgcn_permlane16_swap(__float_as_uint(y[i]), __float_as_uint(y[4 + i]), false, false); z[i] = __uint_as_float(r[0]) + __uint_as_float(r[1]); }
#pragma unroll
    for (int i = 0; i < 2; ++i) { const float keep = b3 ? z[2 + i] : z[i], send = b3 ? z[i] : z[2 + i]; u[i] = keep + dpp_mov<0x128>(send); }
    const float keep = b2 ? u[1] : u[0], send = b2 ? u[0] : u[1]; float t = keep + dpp_mov<0x141>(send);
    t += dpp_mov<0x4E>(t); t += dpp_mov<0xB1>(t);
    return t;
}
__device__ __forceinline__ void ln_inplace_lds(float (&v)[16], LAS const float* gb, int lane) {
    float s = 0.f;
#pragma unroll
    for (int i = 0; i < 16; ++i) s += v[i];
    const float mean = wave_sum(s, lane) * (1.0f / D); float q = 0.f;
#pragma unroll
    for (int i = 0; i < 16; ++i) { v[i] -= mean; q += v[i] * v[i]; }
    const float rstd = __builtin_amdgcn_rsqf(wave_sum(q, lane) * (1.0f / D) + LN_EPS);
#pragma unroll
    for (int hh = 0; hh < 4; ++hh) { const f32x4 g4 = *(LAS const f32x4*)(gb + hh * 256 + lane * 4), b4 = *(LAS const f32x4*)(gb + (4 + hh) * 256 + lane * 4);
#pragma unroll
        for (int i = 0; i < 4; ++i) v[4 * hh + i] = v[4 * hh + i] * rstd * g4[i] + b4[i]; }
}
__device__ __forceinline__ void unpack_row(const u32x4 a, const u32x4 b, float (&v)[16]) {
    float t[8]; unpack8(a, t);
#pragma unroll
    for (int i = 0; i < 8; ++i) v[i] = t[i];
    unpack8(b, t);
#pragma unroll
    for (int i = 0; i < 8; ++i) v[8 + i] = t[i];
}

__device__ __forceinline__ void transpose_item(const float* src, int lds_, bf16_t* dst, int ldd, LAS float* scr, int lane) {
#pragma unroll 8
    for (int i = 0; i < 32; ++i) { const int kk = 2 * i + (lane >> 5); scr[kk * 33 + (lane & 31)] = src[(size_t)kk * lds_ + (lane & 31)]; }
    LDS_WAIT(); asm volatile("" ::: "memory");
    const int c = lane & 7;
#pragma unroll
    for (int j = 0; j < 4; ++j) { const int n = (lane >> 3) + 8 * j; const LAS float* s = scr + (8 * c) * 33 + n;
        u32x4 o; o.x = pk2(s[0 * 33], s[1 * 33]); o.y = pk2(s[2 * 33], s[3 * 33]); o.z = pk2(s[4 * 33], s[5 * 33]); o.w = pk2(s[6 * 33], s[7 * 33]);
        *(u32x4*)(dst + (size_t)n * ldd + 8 * c) = o; }
    LDS_WAIT(); asm volatile("" ::: "memory");
}
__device__ __forceinline__ void transpose_item_fp8(const float* src, int lds_, unsigned char* dst8, int ldd8, float scale, LAS float* scr, int lane) {
#pragma unroll 8
    for (int i = 0; i < 32; ++i) { const int kk = 2 * i + (lane >> 5); scr[kk * 33 + (lane & 31)] = src[(size_t)kk * lds_ + (lane & 31)]; }
    LDS_WAIT(); asm volatile("" ::: "memory");
    const int c = lane & 7;
#pragma unroll
    for (int j = 0; j < 4; ++j) { const int n = (lane >> 3) + 8 * j; const LAS float* s = scr + (8 * c) * 33 + n;
        u32x2 o; o.x = pack4_fp8c((f32x4){s[0 * 33], s[1 * 33], s[2 * 33], s[3 * 33]}, scale); o.y = pack4_fp8c((f32x4){s[4 * 33], s[5 * 33], s[6 * 33], s[7 * 33]}, scale);
        *(u32x2*)(dst8 + (size_t)n * ldd8 + 8 * c) = o; }
    LDS_WAIT(); asm volatile("" ::: "memory");
}
__device__ __forceinline__ void p0_prologue(const Ctx& F) {
    LAS float* scr = (LAS float*)(F.lds + 32768 + F.wave * 8704);
    const int gw = F.wg * NWAVES + F.wave, NGW = F.G * NWAVES;
    constexpr int I_IN = 16 * 112, I_OUT = 16 * 32, I_GU = 16 * 16 * 32, I_DN = 16 * 8 * 32, I_L = I_IN + I_OUT + I_GU + I_DN;
    bf16_t* WIN = (bf16_t*)(F.ws + WS_WIN); bf16_t* WOUT = (bf16_t*)(F.ws + WS_WOUT); bf16_t* WGU = (bf16_t*)(F.ws + WS_WGU); bf16_t* WDN = (bf16_t*)(F.ws + WS_WDN);
    for (int it = gw; it < DEPTH * I_L; it += NGW) {
        const int l = it / I_L; int r = it % I_L;
        if (r < I_IN) { const int kb = r / 112, nb = r % 112, n0 = 32 * nb, grp = n0 >> 9;
            const int src0 = win_src_col(n0); (void)grp;
            transpose_item_fp8(F.w_in + ((size_t)l * D + 64 * kb) * PIN + src0, PIN, (unsigned char*)WIN + ((size_t)l * NP + n0) * D + 64 * kb, D, WIN_SCALE, scr, F.lane); continue; }
        r -= I_IN;
        if (r < I_OUT) { const int kb = r / 32, nb = r % 32;
            transpose_item_fp8(F.w_out + ((size_t)l * D + 64 * kb) * D + 32 * nb, D, (unsigned char*)WOUT + ((size_t)l * D + 32 * nb) * D + 64 * kb, D, WOUT_SCALE, scr, F.lane); continue; }
        r -= I_OUT;
        if (r < I_GU) { const int e = r / 512, q = r % 512, kb = q / 32, nb = q % 32, n0 = 32 * nb;
            const int pn = n0 >> 8, w = n0 & 255; const float* srcm = ((w >> 5) & 1) ? F.w_up : F.w_gate; const int scol = pn * 128 + 32 * (w >> 6);
            transpose_item_fp8(srcm + (((size_t)l * NE + e) * D + 64 * kb) * DFF + scol, DFF, (unsigned char*)WGU + (((size_t)l * NE + e) * 1024 + n0) * D + 64 * kb, D, WGU_SCALE, scr, F.lane); continue; }
        r -= I_GU;
        { const int e = r / 256, q = r % 256, kb = q / 32, nb = q % 32;
            transpose_item_fp8(F.w_down + (((size_t)l * NE + e) * DFF + 64 * kb) * D + 32 * nb, D, (unsigned char*)WDN + (((size_t)l * NE + e) * D + 32 * nb) * DFF + 64 * kb, DFF, WDN_SCALE, scr, F.lane); }
    }
    { u32x4* RFB = (u32x4*)(F.ws + WS_RFB);
      for (int idx = F.wg * NTHR + F.tid; idx < 32 * 64; idx += F.G * NTHR) { const int kk = idx >> 6, ln = idx & 63, rr = ln & 15, qq = ln >> 4; float w[8], wl[8];
#pragma unroll
          for (int i = 0; i < 8; ++i) w[i] = F.router_w[(size_t)(32 * kk + 8 * qq + i) * 16 + rr];
          const u32x4 hi = pack8(w); float hf[8]; unpack8(hi, hf);
#pragma unroll
          for (int i = 0; i < 8; ++i) wl[i] = w[i] - hf[i];
          RFB[(kk * 2) * 64 + ln] = hi; RFB[(kk * 2 + 1) * 64 + ln] = pack8(wl); }
      float* WIFP = (float*)(F.ws + WS_WIFP);
      for (int idx = F.wg * NTHR + F.tid; idx < DEPTH * D; idx += F.G * NTHR) { const int ll = idx >> 10, k = idx & 1023; const float* src = F.w_in + ((size_t)ll * D + k) * PIN + SRC_IF; const f32x4 a = *(const f32x4*)src, b = *(const f32x4*)(src + 4);
          float* dst = WIFP + (size_t)ll * 8 * D;
          dst[wperm_idx(0, k)] = a[0]; dst[wperm_idx(1, k)] = a[1]; dst[wperm_idx(2, k)] = a[2]; dst[wperm_idx(3, k)] = a[3]; dst[wperm_idx(4, k)] = b[0]; dst[wperm_idx(5, k)] = b[1]; dst[wperm_idx(6, k)] = b[2]; dst[wperm_idx(7, k)] = b[3]; } }
    LAS float* wif = (LAS float*)F.lds;
    fill_wif(F, 0, wif);
    __syncthreads();
    bf16_t* X = (bf16_t*)(F.ws + WS_X); float* GATES = (float*)(F.ws + WS_GATES);
    const int npair = M / (2 * NGW);
    f32x4 raw[2][4];
#pragma unroll
    for (int rr = 0; rr < 2; ++rr) { const float* row = F.x + (size_t)(gw + NGW * rr) * D;
#pragma unroll
        for (int jq = 0; jq < 4; ++jq) raw[rr][jq] = *(const f32x4*)(row + 512 * (jq >> 1) + 8 * F.lane + 4 * (jq & 1)); }
    for (int it = 0; it < npair; ++it) {
        float v[2][16];
#pragma unroll
        for (int rr = 0; rr < 2; ++rr)
#pragma unroll
            for (int jq = 0; jq < 4; ++jq) { v[rr][4 * jq] = raw[rr][jq][0]; v[rr][4 * jq + 1] = raw[rr][jq][1]; v[rr][4 * jq + 2] = raw[rr][jq][2]; v[rr][4 * jq + 3] = raw[rr][jq][3]; }
        if (it + 1 < npair) {
#pragma unroll
            for (int rr = 0; rr < 2; ++rr) { const float* row = F.x + (size_t)(gw + NGW * (2 * it + 2 + rr)) * D;
#pragma unroll
                for (int jq = 0; jq < 4; ++jq) raw[rr][jq] = *(const f32x4*)(row + 512 * (jq >> 1) + 8 * F.lane + 4 * (jq & 1)); } }
        float part[16]; row_dots<2, 8>(v, wif, F.lane, part);
        const float tot = reduce16(part, F.lane);
#pragma unroll
        for (int rr = 0; rr < 2; ++rr) store_row_bf16(X + (size_t)(gw + NGW * (2 * it + rr)) * D, F.lane, v[rr]);
#pragma unroll
        for (int rr = 0; rr < 2; ++rr)
#pragma unroll
            for (int j = 0; j < 2; ++j) { u32x2 f8; f8.x = pack4_fp8c((f32x4){v[rr][8 * j], v[rr][8 * j + 1], v[rr][8 * j + 2], v[rr][8 * j + 3]}, 1.0f); f8.y = pack4_fp8c((f32x4){v[rr][8 * j + 4], v[rr][8 * j + 5], v[rr][8 * j + 6], v[rr][8 * j + 7]}, 1.0f);
                *(u32x2*)(F.ws + WS_XF + (size_t)(gw + NGW * (2 * it + rr)) * D + 512 * j + 8 * F.lane) = f8; }
        if ((F.lane & 3) == 0) { const int ix = idx16(F.lane), rr = ix >> 3, j = ix & 7; GATES[(size_t)(gw + NGW * (2 * it + rr)) * 8 + j] = tot + F.b_in[SRC_IF + j]; }
    }
}

typedef short s16x4 __attribute__((ext_vector_type(4)));
__device__ __forceinline__ void tr_issue(s16x4& d, unsigned addr) { asm volatile("ds_read_b64_tr_b16 %0, %1" : "=&v"(d) : "v"(addr) : "memory"); }
#define TR_ISSUE_OFF(d, addr, off) asm volatile("ds_read_b64_tr_b16 %0, %1 offset:%2" : "=&v"(d) : "v"(addr), "i"(off) : "memory")
#define TR_WAIT4(a, b, c, d) asm volatile("s_waitcnt lgkmcnt(0)" : "+v"(a), "+v"(b), "+v"(c), "+v"(d) :: "memory")
#define TR_WAIT2(a, b) asm volatile("s_waitcnt lgkmcnt(0)" : "+v"(a), "+v"(b) :: "memory")
#define TR_WAIT8(a, b, c, d, e, f, g, h) asm volatile("s_waitcnt lgkmcnt(0)" : "+v"(a), "+v"(b), "+v"(c), "+v"(d), "+v"(e), "+v"(f), "+v"(g), "+v"(h) :: "memory")
__device__ __forceinline__ bf16x8 cat8(s16x4 lo, s16x4 hi) { return __builtin_shufflevector(lo, hi, 0, 1, 2, 3, 4, 5, 6, 7); }

__device__ __forceinline__ float wave_incl_scan_add(float x, int lane) {
#pragma unroll
    for (int o = 1; o < 64; o <<= 1) { const float t = shup(x, o, lane); if (lane >= o) x += t; }
    return x;
}
__device__ __forceinline__ float wave_incl_scan_max(float x, int lane) {
#pragma unroll
    for (int o = 1; o < 64; o <<= 1) { const float t = shup(x, o, lane); if (lane >= o) x = fmaxf(x, t); }
    return x;
}
__device__ __forceinline__ float log_sigmoid(float f) { return fminf(f, 0.f) - log1pf(expf(-fabsf(f))); }
__device__ __forceinline__ int off_tr2(int row, int ch) { return row * 256 + ((ch ^ (2 * ((row & 3) | ((row >> 1) & 4)))) << 4); }

__device__ __forceinline__ void p2_local_conv(const Ctx& F, int l) {
    const float* GATES = (const float*)(F.ws + WS_GATES);
    unsigned char* CS = F.ws + WS_CS; float* AA = (float*)(F.ws + WS_AA); float* BB = (float*)(F.ws + WS_BB); float* NL = (float*)(F.ws + WS_NL);
    float* ML = (float*)(F.ws + WS_ML); float* GC = (float*)(F.ws + WS_GC);
    LAS float* se = (LAS float*)(F.lds + 65536);
    const int w = F.wave, r = F.lane & 15, q = F.lane >> 4;
    const int rowl = 8 * q + (r >> 2);
    unsigned a2[8];
#pragma unroll
    for (int ct = 0; ct < 8; ++ct) a2[ct] = (unsigned)(off_tr2(rowl, 2 * ct + ((r & 3) >> 1)) + 8 * (r & 1));
    const unsigned a2k = (unsigned)(off_tr2(rowl, 2 * w + ((r & 3) >> 1)) + 8 * (r & 1));
    const int NU = NB * NH * NCH;
    u32x4 kreg[2], vreg[2]; const unsigned char* CVp = F.ws + WS_CV;
    int u = F.wg;
    if (u < NU) { const int c = u % NCH, h = (u / NCH) % NH, b = u / (NCH * NH), t0 = b * SEQ + c * CHK;
#pragma unroll
        for (int i = 0; i < 2; ++i) { const int cq = F.tid + NTHR * i, row = cq >> 3, cp = cq & 7; const unsigned char* src = CVp + (size_t)(t0 + row) * NCV + h * DH + cp * 16;
            kreg[i] = *(const u32x4*)(src + CK); vreg[i] = *(const u32x4*)(src + CVV); } }
    float* PM = (float*)(F.ws + WS_PM);
    for (int k = w; F.wg + k * F.G < NU && k < 16; k += NWAVES) {
        const int uu = F.wg + k * F.G, c = uu % NCH, h = (uu / NCH) % NH, b = uu / (NCH * NH), bh = b * NH + h, t0 = b * SEQ + c * CHK, ln = F.lane;
        const float f0 = GATES[(size_t)(t0 + ln) * 8 + 4 + h], i0 = GATES[(size_t)(t0 + ln) * 8 + h], f1 = GATES[(size_t)(t0 + 64 + ln) * 8 + 4 + h], i1 = GATES[(size_t)(t0 + 64 + ln) * 8 + h];
        const float a0 = wave_incl_scan_add(log_sigmoid(f0), ln); const float tot0 = rdlane(a0, 63);
        const float a1 = wave_incl_scan_add(log_sigmoid(f1), ln) + tot0; const float g = rdlane(a1, 63);
        const float b0 = i0 - a0, b1 = i1 - a1;
        const float m0 = wave_incl_scan_max(b0, ln); const float t0m = rdlane(m0, 63); const float m1 = fmaxf(wave_incl_scan_max(b1, ln), t0m); const float maxb = rdlane(m1, 63);
        const float sc = 0.08838834764831845f;
        se[k * 128 + ln] = expf(b0 - maxb) * sc; se[k * 128 + 64 + ln] = expf(b1 - maxb) * sc;
        const size_t o = (size_t)bh * SEQ + c * CHK + ln; AA[o] = a0; AA[o + 64] = a1; BB[o] = b0; BB[o + 64] = b1; PM[o] = m0; PM[o + 64] = m1;
        if (ln == 0) { ML[bh * NCH + c] = g + maxb; GC[bh * NCH + c] = g; }
    }
    bf16_t* Y = (bf16_t*)F.out; const unsigned char* CV = F.ws + WS_CV;
#define CV_LOAD8(dst, p_) do { const u32x2 w_ = *(const u32x2*)(p_); const f32x4 lo_ = unpack4_fp8(w_.x), hi_ = unpack4_fp8(w_.y); dst[0] = lo_[0]; dst[1] = lo_[1]; dst[2] = lo_[2]; dst[3] = lo_[3]; dst[4] = hi_[0]; dst[5] = hi_[1]; dst[6] = hi_[2]; dst[7] = hi_[3]; } while (0)
    const int ch0 = 8 * F.lane, ts = (F.wg * NWAVES + F.wave) * 32;
    float um1[8], um2[8];
    LAS float* cwl = (LAS float*)(F.lds + 65536 + 8192);
    for (int i = F.tid; i < 3 * 512; i += NTHR) cwl[i] = F.conv_w[(size_t)l * 3 * 512 + i];
#define CW_LOAD() float w0[8], w1[8], w2[8]; do { _Pragma("unroll") for (int qq = 0; qq < 2; ++qq) { const f32x4 a = *(LAS const f32x4*)(cwl + ch0 + 4 * qq), b = *(LAS const f32x4*)(cwl + 512 + ch0 + 4 * qq), c = *(LAS const f32x4*)(cwl + 1024 + ch0 + 4 * qq); \
          _Pragma("unroll") for (int j = 0; j < 4; ++j) { w0[4 * qq + j] = a[j]; w1[4 * qq + j] = b[j]; w2[4 * qq + j] = c[j]; } } } while (0)
    if ((ts % SEQ) == 0) {
#pragma unroll
        for (int i = 0; i < 8; ++i) { um1[i] = 0.f; um2[i] = 0.f; }
    } else { float a[8], b[8];
        CV_LOAD8(a, CV + (size_t)(ts - 1) * NCV + CU + ch0); CV_LOAD8(b, CV + (size_t)(ts - 2) * NCV + CU + ch0);
#pragma unroll
        for (int i = 0; i < 8; ++i) { um1[i] = a[i]; um2[i] = b[i]; } }
    __syncthreads();
    int kidx = 0;
    for (; u < NU; u += F.G, ++kidx) {
        const int c = u % NCH, h = (u / NCH) % NH, b = u / (NCH * NH), bh = b * NH + h, t0 = b * SEQ + c * CHK;
#pragma unroll
        for (int i = 0; i < 2; ++i) { const int cq = F.tid + NTHR * i, row = cq >> 3, cp = cq & 7;
            *(LAS u32x4*)(F.lds + off_tr2(row, 2 * cp)) = fp8x8_to_bf16x8((u32x2){kreg[i].x, kreg[i].y}); *(LAS u32x4*)(F.lds + off_tr2(row, 2 * cp + 1)) = fp8x8_to_bf16x8((u32x2){kreg[i].z, kreg[i].w});
            *(LAS u32x4*)(F.lds + 32768 + off_tr2(row, 2 * cp)) = fp8x8_to_bf16x8((u32x2){vreg[i].x, vreg[i].y}); *(LAS u32x4*)(F.lds + 32768 + off_tr2(row, 2 * cp + 1)) = fp8x8_to_bf16x8((u32x2){vreg[i].z, vreg[i].w}); }
        u32x2 cvr[4][3]; const bool cv_on = kidx < 8;
        if (cv_on) {
#pragma unroll
            for (int tt = 0; tt < 4; ++tt) { const unsigned char* pr = CV + (size_t)(ts + 4 * kidx + tt) * NCV + ch0; cvr[tt][0] = *(const u32x2*)(pr + CU); cvr[tt][2] = *(const u32x2*)(pr + CGB); } }
        { const int un = u + F.G;
          if (un < NU) { const int c2 = un % NCH, h2 = (un / NCH) % NH, b2 = un / (NCH * NH), t2 = b2 * SEQ + c2 * CHK;
#pragma unroll
            for (int i = 0; i < 2; ++i) { const int cq = F.tid + NTHR * i, row = cq >> 3, cp = cq & 7; const unsigned char* src = CVp + (size_t)(t2 + row) * NCV + h2 * DH + cp * 16;
                kreg[i] = *(const u32x4*)(src + CK); vreg[i] = *(const u32x4*)(src + CVV); }
 } }
        __syncthreads();
        f32x4 acc[8], nacc = (f32x4){0.f, 0.f, 0.f, 0.f};
#pragma unroll
        for (int vt = 0; vt < 8; ++vt) acc[vt] = (f32x4){0.f, 0.f, 0.f, 0.f};
        const bf16x8 ones = (bf16x8){(short)0x3F80, (short)0x3F80, (short)0x3F80, (short)0x3F80, (short)0x3F80, (short)0x3F80, (short)0x3F80, (short)0x3F80};
#pragma unroll
        for (int kk = 0; kk < 4; ++kk) {
            s16x4 k0, k1, vv[16]; TR_ISSUE_OFF(k0, a2k, kk * 8192); TR_ISSUE_OFF(k1, a2k, kk * 8192 + 1024);
#pragma unroll
            for (int vp = 0; vp < 4; ++vp) { TR_ISSUE_OFF(vv[4 * vp], a2[2 * vp], 32768 + kk * 8192); TR_ISSUE_OFF(vv[4 * vp + 1], a2[2 * vp], 32768 + kk * 8192 + 1024);
                TR_ISSUE_OFF(vv[4 * vp + 2], a2[2 * vp + 1], 32768 + kk * 8192); TR_ISSUE_OFF(vv[4 * vp + 3], a2[2 * vp + 1], 32768 + kk * 8192 + 1024); }
            const f32x4 e0 = *(LAS const f32x4*)(se + kidx * 128 + 32 * kk + 8 * q), e1 = *(LAS const f32x4*)(se + kidx * 128 + 32 * kk + 8 * q + 4);
            TR_WAIT2(k0, k1); TR_WAIT8(vv[0], vv[1], vv[2], vv[3], vv[4], vv[5], vv[6], vv[7]); TR_WAIT8(vv[8], vv[9], vv[10], vv[11], vv[12], vv[13], vv[14], vv[15]);
            float kf[8]; { u32x4 kw; const u32x2 lo = __builtin_bit_cast(u32x2, k0), hi = __builtin_bit_cast(u32x2, k1); kw.x = lo.x; kw.y = lo.y; kw.z = hi.x; kw.w = hi.y; unpack8(kw, kf); }
            kf[0] *= e0[0]; kf[1] *= e0[1]; kf[2] *= e0[2]; kf[3] *= e0[3]; kf[4] *= e1[0]; kf[5] *= e1[1]; kf[6] *= e1[2]; kf[7] *= e1[3];
            const bf16x8 kfs = __builtin_bit_cast(bf16x8, pack8(kf));
            nacc = __builtin_amdgcn_mfma_f32_16x16x32_bf16(ones, kfs, nacc, 0, 0, 0);
#pragma unroll
            for (int vp = 0; vp < 4; ++vp) {
                acc[2 * vp] = __builtin_amdgcn_mfma_f32_16x16x32_bf16(cat8(vv[4 * vp], vv[4 * vp + 1]), kfs, acc[2 * vp], 0, 0, 0);
                acc[2 * vp + 1] = __builtin_amdgcn_mfma_f32_16x16x32_bf16(cat8(vv[4 * vp + 2], vv[4 * vp + 3]), kfs, acc[2 * vp + 1], 0, 0, 0); }
        }
        MFMA_DRAIN();
        unsigned char* Cout = CS + ((size_t)bh * NCH + c) * (DH * DH) + (size_t)(16 * w + r) * DH + 16 * q;
#pragma unroll
        for (int g4 = 0; g4 < 2; ++g4) { unsigned x[4];
#pragma unroll
            for (int v = 0; v < 4; ++v) x[v] = pack4_fp8c(acc[4 * g4 + v], CL_SCALE);
            lane_row_transpose4(x);
            *(u32x4*)(Cout + 64 * g4) = (u32x4){x[0], x[1], x[2], x[3]}; }
        if (q == 0) NL[((size_t)bh * NCH + c) * DH + 16 * w + r] = nacc[0];
        if (cv_on) { CW_LOAD();
#pragma unroll
            for (int tt = 0; tt < 4; ++tt) { float y[8];
#pragma unroll
                for (int hf = 0; hf < 2; ++hf) {
                    const f32x4 uu4 = unpack4_fp8(hf ? cvr[tt][0].y : cvr[tt][0].x), gb4 = unpack4_fp8(hf ? cvr[tt][2].y : cvr[tt][2].x);
                    const f32x4 w04 = (f32x4){w0[4 * hf], w0[4 * hf + 1], w0[4 * hf + 2], w0[4 * hf + 3]}, w14 = (f32x4){w1[4 * hf], w1[4 * hf + 1], w1[4 * hf + 2], w1[4 * hf + 3]}, w24 = (f32x4){w2[4 * hf], w2[4 * hf + 1], w2[4 * hf + 2], w2[4 * hf + 3]};
                    const f32x4 u14 = (f32x4){um1[4 * hf], um1[4 * hf + 1], um1[4 * hf + 2], um1[4 * hf + 3]}, u24 = (f32x4){um2[4 * hf], um2[4 * hf + 1], um2[4 * hf + 2], um2[4 * hf + 3]};
                    const f32x4 y4 = gb4 * (w24 * uu4 + w14 * u14 + w04 * u24);
#pragma unroll
                    for (int i = 0; i < 4; ++i) { y[4 * hf + i] = y4[i]; um2[4 * hf + i] = um1[4 * hf + i]; um1[4 * hf + i] = uu4[i]; } }
                { u32x2 yw; yw.x = pack4_fp8c((f32x4){y[0], y[1], y[2], y[3]}, Y_SCALE); yw.y = pack4_fp8c((f32x4){y[4], y[5], y[6], y[7]}, Y_SCALE); *(u32x2*)((unsigned char*)Y + (size_t)(ts + 4 * kidx + tt) * D + 512 + ch0) = yw; } } }
        __syncthreads();
    }
    if (kidx > 8) kidx = 8;
    for (int tcur = ts + 4 * kidx; tcur < ts + 32; ++tcur) { CW_LOAD(); float gc[8], xc[8], gb[8], y[8]; const unsigned char* pr = CV + (size_t)tcur * NCV + ch0;
        CV_LOAD8(gc, pr + CU); CV_LOAD8(gb, pr + CGB); (void)xc;
#pragma unroll
        for (int i = 0; i < 8; ++i) { const float uu = gc[i]; y[i] = gb[i] * (w2[i] * uu + w1[i] * um1[i] + w0[i] * um2[i]); um2[i] = um1[i]; um1[i] = uu; }
        { u32x2 yw; yw.x = pack4_fp8c((f32x4){y[0], y[1], y[2], y[3]}, Y_SCALE); yw.y = pack4_fp8c((f32x4){y[4], y[5], y[6], y[7]}, Y_SCALE); *(u32x2*)((unsigned char*)Y + (size_t)tcur * D + 512 + ch0) = yw; } }
#undef CV_LOAD8
#undef CW_LOAD
}

__device__ __forceinline__ void p3_scan(const Ctx& F) {
    const unsigned char* CS = F.ws + WS_CS; const float* NL = (const float*)(F.ws + WS_NL); float* NST = (float*)(F.ws + WS_NST); const float* ML = (const float*)(F.ws + WS_ML); const float* GC = (const float*)(F.ws + WS_GC); float* MST = (float*)(F.ws + WS_MST);
    unsigned char* CSB = (unsigned char*)F.out + CSB_OFF;
    static_assert(NCH == 64, "lane c of wave 0 keeps chunk c");
    LAS float* ssp = (LAS float*)F.lds; LAS float* ssl = ssp + NCH;
    for (int it0 = F.wg * NTHR; it0 < 32 * 4096; it0 += F.G * NTHR) {
        const int bh = __builtin_amdgcn_readfirstlane(it0 >> 12), e4 = (it0 & 4095) + F.tid;
        const unsigned* cp = (const unsigned*)(CS + (size_t)bh * NCH * (DH * DH)) + e4; unsigned* op = (unsigned*)(CSB + (size_t)bh * NCH * (DH * DH)) + e4;
        const bool do_n = e4 < DH;
        unsigned cw[NCH]; float vn[NCH];
#pragma unroll
        for (int c = 0; c < NCH; ++c) cw[c] = cp[(size_t)c * 4096];
#pragma unroll
        for (int c = 0; c < NCH; ++c) vn[c] = 0.f;
        if (do_n) {
#pragma unroll
            for (int c = 0; c < NCH; ++c) vn[c] = NL[((size_t)bh * NCH + c) * DH + e4]; }
        __syncthreads();
        if (F.wave == 0) {
            const float mlv = ML[bh * NCH + F.lane], gcv = GC[bh * NCH + F.lane];
            float mprev = 0.f, my_sp = 0.f, my_sl = 0.f, my_m = 0.f;
#pragma unroll
            for (int c = 0; c < NCH; ++c) { const float ml = rdlane(mlv, c), gc = rdlane(gcv, c);
                const float mnew = fmaxf(gc + mprev, ml), sp = __expf(gc + mprev - mnew), sl = __expf(ml - mnew);
                if (F.lane == c) { my_sp = sp; my_sl = sl; my_m = mprev; }
                mprev = mnew; }
            ssp[F.lane] = my_sp; ssl[F.lane] = my_sl; MST[bh * NCH + F.lane] = my_m; }
        __syncthreads();
        f32x4 st = (f32x4){0.f, 0.f, 0.f, 0.f}; float sn = 0.f;
#pragma unroll
        for (int c = 0; c < NCH; ++c) { const float sp = ssp[c], sl = ssl[c];
            op[(size_t)c * 4096] = pack4_fp8c(st, CS_SCALE); if (do_n) NST[((size_t)bh * NCH + c) * DH + e4] = sn;
            const f32x4 v_ = unpack4_fp8(cw[c]) * (1.0f / CL_SCALE);
            st = st * sp + v_ * sl; sn = sn * sp + vn[c] * sl; }
    }
}

__device__ __forceinline__ int off_trv(int row, int ch) { return row * 256 + ((ch ^ (2 * (row & 7))) << 4); }
__device__ __forceinline__ int off_row(int row, int ch) { return row * 256 + ((ch ^ (row & 15)) << 4); }
__device__ __forceinline__ void p4_mlstm_out(const Ctx& F, int l) {
    const unsigned char* WSB = F.ws; const unsigned char* OUTB = (const unsigned char*)F.out;
#define P4_WS16(off_) (*(const u32x4*)(WSB + (unsigned)(off_)))
#define P4_WSF(off_) (*(const float*)(WSB + (unsigned)(off_)))
#define P4_WS8(off_) (*(const u32x2*)(WSB + (unsigned)(off_)))
#define P4_OUT16(off_) (*(const u32x4*)(OUTB + (unsigned)(off_)))
    const unsigned char* CSB = (const unsigned char*)F.out + CSB_OFF;
    const float* AA = (const float*)(F.ws + WS_AA); const float* BB = (const float*)(F.ws + WS_BB); const float* PM = (const float*)(F.ws + WS_PM);
    const float* NL = (const float*)(F.ws + WS_NST); const float* MST = (const float*)(F.ws + WS_MST); bf16_t* Y = (bf16_t*)F.out;
    LAS float* sa = (LAS float*)(F.lds + 98304); LAS float* sb_ = sa + 128; LAS float* sM = sa + 256; LAS float* sn = sa + 384; LAS float* smg = sa + 512;
    smg[F.tid] = F.mh_g[(size_t)l * 512 + F.tid];
    LAS float* slut = sa + 1024;
    if (F.tid < 256) { const f32x2 cv = __builtin_amdgcn_cvt_pk_f32_fp8(F.tid, false); slut[F.tid] = sigmoidf_(cv[0]); }
    const int w = F.wave < 4 ? F.wave : 11 - F.wave, r = F.lane & 15, q = F.lane >> 4;
    const int rowl = 4 * q + (r >> 2);
    unsigned av[8];
#pragma unroll
    for (int vt = 0; vt < 8; ++vt) av[vt] = (unsigned)(off_trv(rowl, 2 * vt + ((r & 3) >> 1)) + 8 * (r & 1));
    unsigned ak[4];
#pragma unroll
    for (int kk = 0; kk < 4; ++kk) ak[kk] = (unsigned)(65536 + 256 * r + 16 * ((4 * kk + q) ^ r));
    const int NU = NB * NH * NCH;
    u32x4 kreg[2], vreg[2], creg[2]; u32x2 qraw[4];
    const unsigned char* CVp = F.ws + WS_CV; float spre[8] = {0.f, 0.f, 0.f, 0.f, 0.f, 0.f, 0.f, 0.f}; float mst_n = 0.f;
#define P4_SMALL(bh_, c_) do { mst_n = P4_WSF((unsigned)WS_MST + (unsigned)((bh_) * NCH + (c_)) * 4u); if (w == 0) { const unsigned o_ = (unsigned)((bh_) * SEQ + (c_) * CHK + F.lane) * 4u; spre[0] = P4_WSF((unsigned)WS_AA + o_); spre[1] = P4_WSF((unsigned)WS_AA + o_ + 256u); spre[2] = P4_WSF((unsigned)WS_BB + o_); spre[3] = P4_WSF((unsigned)WS_BB + o_ + 256u); \
        const unsigned n_ = (unsigned)(((bh_) * NCH + (c_)) * DH + F.lane) * 4u; spre[4] = P4_WSF((unsigned)WS_NST + n_); spre[5] = P4_WSF((unsigned)WS_NST + n_ + 256u); spre[6] = P4_WSF((unsigned)WS_PM + o_); spre[7] = P4_WSF((unsigned)WS_PM + o_ + 256u); } } while (0)
    int u = F.wg;
    if (u < NU) { const int c = u % NCH, h = (u / NCH) % NH, b = u / (NCH * NH), bh = b * NH + h, t0 = b * SEQ + c * CHK;
        P4_SMALL(bh, c);
#pragma unroll
        for (int i = 0; i < 2; ++i) { const int cq = F.tid + NTHR * i, row = cq >> 3, cp = cq & 7; kreg[i] = P4_WS16((unsigned)WS_CV + (unsigned)((t0 + row) * NCV + CK + h * DH + cp * 16)); }
#pragma unroll
        for (int i = 0; i < 2; ++i) { const int cq = F.tid + NTHR * i, row = cq >> 3, cp = cq & 7;
            vreg[i] = P4_WS16((unsigned)WS_CV + (unsigned)((t0 + row) * NCV + CVV + h * DH + cp * 16));
            creg[i] = P4_OUT16((unsigned)CSB_OFF + (unsigned)((bh * NCH + c) * (DH * DH) + row * DH + cp * 16)); }
#pragma unroll
        for (int kk = 0; kk < 4; ++kk) qraw[kk] = P4_WS8((unsigned)WS_CV + (unsigned)((t0 + 16 * w + r) * NCV + CQ + h * DH + 32 * kk + 8 * q)); }
    for (; u < NU; u += F.G) {
        const int c = u % NCH, h = (u / NCH) % NH, b = u / (NCH * NH), bh = b * NH + h, t0 = b * SEQ + c * CHK;
        const float mst = mst_n;
#pragma unroll
        for (int i = 0; i < 2; ++i) { const int cq = F.tid + NTHR * i, row = cq >> 3, cp = cq & 7;
            *(LAS u32x4*)(F.lds + 65536 + off_row(row, 2 * cp)) = fp8x8_to_bf16x8((u32x2){kreg[i].x, kreg[i].y}); *(LAS u32x4*)(F.lds + 65536 + off_row(row, 2 * cp + 1)) = fp8x8_to_bf16x8((u32x2){kreg[i].z, kreg[i].w}); }
#pragma unroll
        for (int i = 0; i < 2; ++i) { const int cq = F.tid + NTHR * i, row = cq >> 3, cp = cq & 7;
            const int rho = (row & ~31) | ((row & 4) << 2) | ((row >> 1) & 12) | (row & 3);
            *(LAS u32x4*)(F.lds + off_trv(row, 2 * cp)) = fp8x8_to_bf16x8((u32x2){vreg[i].x, vreg[i].y}); *(LAS u32x4*)(F.lds + off_trv(row, 2 * cp + 1)) = fp8x8_to_bf16x8((u32x2){vreg[i].z, vreg[i].w});
            *(LAS u32x4*)(F.lds + 32768 + off_trv(rho, 2 * cp)) = fp8x8_to_bf16x8((u32x2){creg[i].x, creg[i].y}); *(LAS u32x4*)(F.lds + 32768 + off_trv(rho, 2 * cp + 1)) = fp8x8_to_bf16x8((u32x2){creg[i].z, creg[i].w}); }
        if (w == 0) { const int ln = F.lane;
            sa[ln] = spre[0]; sa[64 + ln] = spre[1]; sb_[ln] = spre[2]; sb_[64 + ln] = spre[3]; sM[ln] = fmaxf(spre[6], mst); sM[64 + ln] = fmaxf(spre[7], mst);
            sn[ln] = spre[4]; sn[64 + ln] = spre[5]; }
        { const int un = u + F.G;
          if (un < NU) { const int c2 = un % NCH, h2 = (un / NCH) % NH, b2 = un / (NCH * NH), bh2 = b2 * NH + h2, t2 = b2 * SEQ + c2 * CHK;
#pragma unroll
            for (int i = 0; i < 2; ++i) { const int cq = F.tid + NTHR * i, row = cq >> 3, cp = cq & 7; kreg[i] = P4_WS16((unsigned)WS_CV + (unsigned)((t2 + row) * NCV + CK + h2 * DH + cp * 16)); }
#pragma unroll
            for (int i = 0; i < 2; ++i) { const int cq = F.tid + NTHR * i, row = cq >> 3, cp = cq & 7;
                vreg[i] = P4_WS16((unsigned)WS_CV + (unsigned)((t2 + row) * NCV + CVV + h2 * DH + cp * 16));
                creg[i] = P4_OUT16((unsigned)CSB_OFF + (unsigned)((bh2 * NCH + c2) * (DH * DH) + row * DH + cp * 16)); }
            P4_SMALL(bh2, c2); } }
        u32x4 qf[4];
#pragma unroll
        for (int kk = 0; kk < 4; ++kk) qf[kk] = fp8x8_to_bf16x8(qraw[kk]);
        const bf16x8 q0 = __builtin_bit_cast(bf16x8, qf[0]), q1 = __builtin_bit_cast(bf16x8, qf[1]), q2 = __builtin_bit_cast(bf16x8, qf[2]), q3 = __builtin_bit_cast(bf16x8, qf[3]);
        __syncthreads();
        const int j = 16 * w + r; const float Mj = sM[j], aj = sa[j];
        float qn = 0.f;
#pragma unroll
        for (int kk = 0; kk < 4; ++kk) { float qv[8]; unpack8(qf[kk], qv);
            const f32x4 n0 = *(LAS const f32x4*)(sn + 32 * kk + 8 * q), n1 = *(LAS const f32x4*)(sn + 32 * kk + 8 * q + 4);
            qn += qv[0] * n0[0] + qv[1] * n0[1] + qv[2] * n0[2] + qv[3] * n0[3] + qv[4] * n1[0] + qv[5] * n1[1] + qv[6] * n1[2] + qv[7] * n1[3]; }
        float rs = 0.f; bf16x8 pf[4];
#pragma unroll
        for (int k2 = 0; k2 < 4; ++k2) {
            u32x4 pw = (u32x4){0u, 0u, 0u, 0u};
            if (2 * k2 <= w) {
                float pv[2][4]; f32x4 sacc[2]; const bool two = (2 * k2 + 1 <= w);
#pragma unroll
                for (int hh = 0; hh < 2; ++hh) { const int n = 2 * k2 + hh; sacc[hh] = (f32x4){0.f, 0.f, 0.f, 0.f};
                    if (hh == 0 || two) {
                        const bf16x8 k0 = *(const LAS bf16x8*)(F.lds + ak[0] + 4096 * n), k1 = *(const LAS bf16x8*)(F.lds + ak[1] + 4096 * n), k2f = *(const LAS bf16x8*)(F.lds + ak[2] + 4096 * n), k3 = *(const LAS bf16x8*)(F.lds + ak[3] + 4096 * n);
                        sacc[hh] = __builtin_amdgcn_mfma_f32_16x16x32_bf16(k0, q0, sacc[hh], 0, 0, 0); sacc[hh] = __builtin_amdgcn_mfma_f32_16x16x32_bf16(k1, q1, sacc[hh], 0, 0, 0);
                        sacc[hh] = __builtin_amdgcn_mfma_f32_16x16x32_bf16(k2f, q2, sacc[hh], 0, 0, 0); sacc[hh] = __builtin_amdgcn_mfma_f32_16x16x32_bf16(k3, q3, sacc[hh], 0, 0, 0); } }
                MFMA_DRAIN();
#pragma unroll
                for (int hh = 0; hh < 2; ++hh) { const int n = 2 * k2 + hh;
                    if (hh == 0 || two) { const f32x4 bv = *(LAS const f32x4*)(sb_ + 16 * n + 4 * q);
                        const f32x4 d4 = (bv - Mj) * 1.4426950408889634f;
                        const f32x4 e4 = (f32x4){__builtin_amdgcn_exp2f(d4[0]), __builtin_amdgcn_exp2f(d4[1]), __builtin_amdgcn_exp2f(d4[2]), __builtin_amdgcn_exp2f(d4[3])};
                        const f32x4 val4 = (sacc[hh] * 0.08838834764831845f) * e4;
#pragma unroll
                        for (int t = 0; t < 4; ++t) { float val = val4[t]; if (n == w && (4 * q + t) > r) val = 0.f; rs += val; pv[hh][t] = val; } }
                    else {
#pragma unroll
                        for (int t = 0; t < 4; ++t) pv[hh][t] = 0.f; } }
                pw.x = pk2(pv[0][0], pv[0][1]); pw.y = pk2(pv[0][2], pv[0][3]); pw.z = pk2(pv[1][0], pv[1][1]); pw.w = pk2(pv[1][2], pv[1][3]);
            }
            pf[k2] = __builtin_bit_cast(bf16x8, pw); }
        rs = sum_rows4(rs); qn = sum_rows4(qn);
        f32x4 acc[8];
#pragma unroll
        for (int vt = 0; vt < 8; ++vt) acc[vt] = (f32x4){0.f, 0.f, 0.f, 0.f};
#pragma unroll
        for (int kk = 0; kk < 4; ++kk) { const bf16x8 qb = kk == 0 ? q0 : kk == 1 ? q1 : kk == 2 ? q2 : q3;
            s16x4 cc[16];
#pragma unroll
            for (int vh = 0; vh < 2; ++vh)
#pragma unroll
                for (int i = 0; i < 4; ++i) { TR_ISSUE_OFF(cc[8 * vh + 2 * i], av[4 * vh + i], 32768 + kk * 8192); TR_ISSUE_OFF(cc[8 * vh + 2 * i + 1], av[4 * vh + i], 32768 + kk * 8192 + 4096); }
            TR_WAIT8(cc[0], cc[1], cc[2], cc[3], cc[4], cc[5], cc[6], cc[7]); TR_WAIT8(cc[8], cc[9], cc[10], cc[11], cc[12], cc[13], cc[14], cc[15]);
#pragma unroll
            for (int vt = 0; vt < 8; ++vt) acc[vt] = __builtin_amdgcn_mfma_f32_16x16x32_bf16(cat8(cc[2 * vt], cc[2 * vt + 1]), qb, acc[vt], 0, 0, 0); }
        MFMA_DRAIN();
        const float ei = __expf(mst - Mj); const float eis = ei * (1.0f / CS_SCALE);
#pragma unroll
        for (int vt = 0; vt < 8; ++vt) acc[vt] = acc[vt] * eis;
        { const int un = u + F.G;
          if (un < NU) { const int c2 = un % NCH, h2 = (un / NCH) % NH, b2 = un / (NCH * NH), t2 = b2 * SEQ + c2 * CHK;
#pragma unroll
            for (int kk = 0; kk < 4; ++kk) qraw[kk] = P4_WS8((unsigned)WS_CV + (unsigned)((t2 + 16 * w + r) * NCV + CQ + h2 * DH + 32 * kk + 8 * q)); } }
        u32x4 ogw[2];
#pragma unroll
        for (int g4 = 0; g4 < 2; ++g4) ogw[g4] = P4_WS16((unsigned)WS_CV + (unsigned)((t0 + 16 * w + r) * NCV + CO + h * DH + 64 * g4 + 16 * q));
#pragma unroll
        for (int k2 = 0; k2 < 4; ++k2) {
            if (k2 <= (w >> 1)) { s16x4 vv[16];
#pragma unroll
                for (int vh = 0; vh < 2; ++vh)
#pragma unroll
                    for (int i = 0; i < 4; ++i) { TR_ISSUE_OFF(vv[8 * vh + 2 * i], av[4 * vh + i], k2 * 8192); TR_ISSUE_OFF(vv[8 * vh + 2 * i + 1], av[4 * vh + i], k2 * 8192 + 4096); }
                TR_WAIT8(vv[0], vv[1], vv[2], vv[3], vv[4], vv[5], vv[6], vv[7]); TR_WAIT8(vv[8], vv[9], vv[10], vv[11], vv[12], vv[13], vv[14], vv[15]);
#pragma unroll
                for (int vt = 0; vt < 8; ++vt) acc[vt] = __builtin_amdgcn_mfma_f32_16x16x32_bf16(cat8(vv[2 * vt], vv[2 * vt + 1]), pf[k2], acc[vt], 0, 0, 0); } }
        MFMA_DRAIN();
        const float den = rs + ei * qn; const float inv = __builtin_amdgcn_rcpf(fmaxf(fabsf(den), __expf(-aj - Mj)));
        float s1 = 0.f;
#pragma unroll
        for (int vt = 0; vt < 8; ++vt) acc[vt] = acc[vt] * inv;
        { f32x4 s4 = acc[0];
#pragma unroll
          for (int vt = 1; vt < 8; ++vt) s4 += acc[vt];
          s1 = (s4[0] + s4[1]) + (s4[2] + s4[3]); }
        s1 = sum_rows4(s1);
        const float mean = s1 * (1.0f / DH); float s2 = 0.f;
        { f32x4 q4 = (f32x4){0.f, 0.f, 0.f, 0.f};
#pragma unroll
          for (int vt = 0; vt < 8; ++vt) { acc[vt] = acc[vt] - mean; q4 += acc[vt] * acc[vt]; }
          s2 = (q4[0] + q4[1]) + (q4[2] + q4[3]); }
        s2 = sum_rows4(s2);
        const float rstd = __builtin_amdgcn_rsqf(s2 * (1.0f / DH) + LN_EPS);
        LAS const float* gp = smg + h * DH + 4 * q; unsigned char* yp = (unsigned char*)F.out + (unsigned)((t0 + j) * D + h * DH + 16 * q);
#pragma unroll
        for (int g4 = 0; g4 < 2; ++g4) { unsigned og[4] = {ogw[g4].x, ogw[g4].y, ogw[g4].z, ogw[g4].w}; lane_row_transpose4(og);
            unsigned yw[4];
#pragma unroll
            for (int v = 0; v < 4; ++v) { const int vt = 4 * g4 + v; const f32x4 g4v = *(LAS const f32x4*)(gp + 16 * vt);
                const unsigned ow = og[v];
                const f32x4 sg = (f32x4){*(LAS const float*)((LAS const char*)slut + ((ow << 2) & 0x3fcu)), *(LAS const float*)((LAS const char*)slut + ((ow >> 6) & 0x3fcu)),
                                         *(LAS const float*)((LAS const char*)slut + ((ow >> 14) & 0x3fcu)), *(LAS const float*)((LAS const char*)slut + ((ow >> 22) & 0x3fcu))};
                const f32x4 y4 = (acc[vt] * rstd) * (g4v * sg);
                yw[v] = pack4_fp8c(y4, Y_SCALE); }
            lane_row_transpose4(yw);
            *(u32x4*)(yp + 64 * g4) = (u32x4){yw[0], yw[1], yw[2], yw[3]}; }
        __syncthreads();
    }
#undef P4_SMALL
#undef P4_WS16
#undef P4_WSF
#undef P4_WS8
#undef P4_OUT16
}

__device__ __forceinline__ void route_select(const float (&lg)[16], int& be0, int& be1, float& g0, float& g1) {
    float mx = lg[0];
#pragma unroll
    for (int e = 1; e < 16; ++e) mx = fmaxf(mx, lg[e]);
    float p[16];
#pragma unroll
    for (int e = 0; e < 16; ++e) p[e] = expf(lg[e] - mx);
    float best = -1.f, bp0 = 0.f, bp1 = 0.f; be0 = 0; be1 = 1;
#pragma unroll
    for (int g = 0; g < 4; ++g) { const float a0 = p[4 * g], a1 = p[4 * g + 1], a2 = p[4 * g + 2], a3 = p[4 * g + 3];
        int i0 = 0; float v0 = a0; if (a1 > v0) { v0 = a1; i0 = 1; } if (a2 > v0) { v0 = a2; i0 = 2; } if (a3 > v0) { v0 = a3; i0 = 3; }
        int i1 = 0; float v1 = -1.f;
        if (i0 != 0 && a0 > v1) { v1 = a0; i1 = 0; } if (i0 != 1 && a1 > v1) { v1 = a1; i1 = 1; } if (i0 != 2 && a2 > v1) { v1 = a2; i1 = 2; } if (i0 != 3 && a3 > v1) { v1 = a3; i1 = 3; }
        const float sg = v0 + v1; if (sg > best) { best = sg; be0 = 4 * g + i0; be1 = 4 * g + i1; bp0 = v0; bp1 = v1; } }
    const float inv = 1.0f / (bp0 + bp1); g0 = bp0 * inv; g1 = bp1 * inv;
}
__device__ __forceinline__ void p6_ln_router(const Ctx& F, int l, int cbank) {
    const bf16_t* PRE = (const bf16_t*)(F.ws + WS_PRE); bf16_t* X = (bf16_t*)(F.ws + WS_X);
    int* TL = (int*)(F.ws + WS_TLIST); float* GL = (float*)(F.ws + WS_GLIST);
    unsigned* CNT = (unsigned*)(F.ws + WS_CTL) + CW_CNT + 64 * cbank;
    LAS u32x4* fb = (LAS u32x4*)F.lds;
    LAS float* gt = (LAS float*)(F.lds + 65536); LAS float* bt = gt + 1024;
    LAS int* lcnt = (LAS int*)(F.lds + 73728); LAS int* lbase = lcnt + 16; LAS int* rec = (LAS int*)(F.lds + 73728 + 256);
    LAS float* lgw = (LAS float*)(F.lds + 73728 + 256 + 16384) + F.wave * 256;
    const int r = F.lane & 15, q = F.lane >> 4;
    const int rpw = (M + F.G - 1) / F.G, r0 = F.wg * rpw;
    u32x4 raw[32];
    if (F.wave < rpw / 16) { const bf16_t* rowp = PRE + (size_t)(r0 + 16 * F.wave + r) * D + 8 * q;
#pragma unroll
        for (int kk = 0; kk < 32; ++kk) raw[kk] = *(const u32x4*)(rowp + 32 * kk); }
    { const u32x4* RFB = (const u32x4*)(F.ws + WS_RFB);
#pragma unroll
      for (int j = 0; j < 8; ++j) fb[F.tid + NTHR * j] = RFB[F.tid + NTHR * j]; }
    for (int i = F.tid; i < D; i += NTHR) { gt[i] = F.ln_mix_g[(size_t)l * D + i]; bt[i] = F.ln_mix_b[(size_t)l * D + i]; }
    if (F.tid < 16) lcnt[F.tid] = 0;
    __syncthreads();
    float rb[16];
#pragma unroll
    for (int e = 0; e < 16; ++e) rb[e] = F.router_b[e];
    for (int grp = F.wave; grp < rpw / 16; grp += NWAVES) {
        const int rl0 = 16 * grp; unsigned char* xf = (unsigned char*)F.out + X1F_OFF + (size_t)(r0 + rl0 + r) * D + 8 * q;
        float s1 = 0.f, s2 = 0.f;
#pragma unroll
        for (int kk = 0; kk < 32; ++kk) { float v[8]; unpack8(raw[kk], v);
#pragma unroll
            for (int i = 0; i < 8; ++i) { s1 += v[i]; s2 += v[i] * v[i]; } }
        s1 = sum_rows4(s1); s2 = sum_rows4(s2);
        const float mean = s1 * (1.0f / D); const float rstd = __builtin_amdgcn_rsqf(fmaxf(s2 * (1.0f / D) - mean * mean, 0.f) + LN_EPS);
        if (q == 0) *(f32x2*)(F.ws + WS_RE + (size_t)(r0 + rl0 + r) * 8) = (f32x2){mean, rstd};
#pragma unroll
        for (int kk = 0; kk < 32; ++kk) asm volatile("" : "+v"(raw[kk]));
        f32x4 acc = (f32x4){0.f, 0.f, 0.f, 0.f};
#pragma unroll
        for (int kk = 0; kk < 32; ++kk) { float v[8], x1[8], xl[8]; unpack8(raw[kk], v);
            const f32x4 g0 = *(LAS const f32x4*)(gt + 32 * kk + 8 * q), g1 = *(LAS const f32x4*)(gt + 32 * kk + 8 * q + 4), b0 = *(LAS const f32x4*)(bt + 32 * kk + 8 * q), b1 = *(LAS const f32x4*)(bt + 32 * kk + 8 * q + 4);
#pragma unroll
            for (int i = 0; i < 4; ++i) { x1[i] = (v[i] - mean) * rstd * g0[i] + b0[i]; x1[4 + i] = (v[4 + i] - mean) * rstd * g1[i] + b1[i]; }
            const u32x4 hi = pack8(x1);
            { u32x2 f8; f8.x = pack4_fp8c((f32x4){x1[0], x1[1], x1[2], x1[3]}, 1.0f); f8.y = pack4_fp8c((f32x4){x1[4], x1[5], x1[6], x1[7]}, 1.0f); *(u32x2*)(xf + 32 * kk) = f8; }
            float hf[8]; unpack8(hi, hf);
#pragma unroll
            for (int i = 0; i < 8; ++i) xl[i] = x1[i] - hf[i];
            const bf16x8 ah = __builtin_bit_cast(bf16x8, hi), al = __builtin_bit_cast(bf16x8, pack8(xl));
            const bf16x8 bh = __builtin_bit_cast(bf16x8, fb[(kk * 2) * 64 + F.lane]), blo = __builtin_bit_cast(bf16x8, fb[(kk * 2 + 1) * 64 + F.lane]);
            acc = __builtin_amdgcn_mfma_f32_16x16x32_bf16(ah, bh, acc, 0, 0, 0);
            acc = __builtin_amdgcn_mfma_f32_16x16x32_bf16(al, bh, acc, 0, 0, 0);
            acc = __builtin_amdgcn_mfma_f32_16x16x32_bf16(ah, blo, acc, 0, 0, 0);
            MFMA_DRAIN(); }
        if (grp + NWAVES < rpw / 16) { const bf16_t* rowp = PRE + (size_t)(r0 + 16 * (grp + NWAVES) + r) * D + 8 * q;
#pragma unroll
            for (int kk = 0; kk < 32; ++kk) raw[kk] = *(const u32x4*)(rowp + 32 * kk); }
#pragma unroll
        for (int t = 0; t < 4; ++t) lgw[(4 * q + t) * 16 + r] = acc[t];
        LDS_WAIT(); asm volatile("" ::: "memory");
        if (F.lane < 16) {
            float lg[16];
#pragma unroll
            for (int q4 = 0; q4 < 4; ++q4) { const f32x4 t4 = *(LAS const f32x4*)(lgw + 16 * F.lane + 4 * q4); lg[4 * q4] = t4[0] + rb[4 * q4]; lg[4 * q4 + 1] = t4[1] + rb[4 * q4 + 1]; lg[4 * q4 + 2] = t4[2] + rb[4 * q4 + 2]; lg[4 * q4 + 3] = t4[3] + rb[4 * q4 + 3]; }
            int e0, e1; float g0, g1; route_select(lg, e0, e1, g0, g1);
            const int rr = rl0 + F.lane;
            const int s0 = atomicAdd((int*)lcnt + e0, 1), s1_ = atomicAdd((int*)lcnt + e1, 1);
            rec[rr * 8 + 0] = e0; rec[rr * 8 + 1] = e1; rec[rr * 8 + 2] = s0; rec[rr * 8 + 3] = s1_; rec[rr * 8 + 4] = __float_as_int(g0); rec[rr * 8 + 5] = __float_as_int(g1); }
        LDS_WAIT(); asm volatile("" ::: "memory");
    }
    __syncthreads();
    if (F.tid < 16) lbase[F.tid] = (int)__hip_atomic_fetch_add(CNT + F.tid, (unsigned)lcnt[F.tid], RLX_AGENT);
    __syncthreads();
    for (int rr = F.tid; rr < rpw; rr += NTHR) { const int m = r0 + rr; if (m >= M) break;
        const int e0 = rec[rr * 8 + 0], e1 = rec[rr * 8 + 1], s0 = lbase[e0] + rec[rr * 8 + 2], s1 = lbase[e1] + rec[rr * 8 + 3];
        TL[(size_t)e0 * M + s0] = 2 * m; TL[(size_t)e1 * M + s1] = 2 * m + 1;   GL[(size_t)e0 * M + s0] = __int_as_float(rec[rr * 8 + 4]); GL[(size_t)e1 * M + s1] = __int_as_float(rec[rr * 8 + 5]); }
}

__device__ __forceinline__ void moe_tables(const Ctx& F, int l) {
    LAS int* tab = (LAS int*)(F.lds + MISC_OFF + 64);
    unsigned* CNT = (unsigned*)(F.ws + WS_CTL) + CW_CNT + 64 * l;
    __syncthreads();
    if (F.tid < 16) tab[F.tid] = (int)__hip_atomic_load(CNT + F.tid, RLX_AGENT);
    __syncthreads();
    if (F.tid == 0) { int s = 0;
        for (int e = 0; e < 16; ++e) { tab[16 + e] = s; s += (tab[e] + 255) >> 8; }
        tab[32] = s; }
    __syncthreads();
}

__device__ __forceinline__ void ln_inplace_lds2(f32x2 (&v)[8], LAS const float* gb, int lane) {
    f32x2 s2 = v[0];
#pragma unroll
    for (int p = 1; p < 8; ++p) s2 += v[p];
    const float mean = wave_sum(s2[0] + s2[1], lane) * (1.0f / D); const f32x2 m2 = (f32x2){mean, mean}; f32x2 q2 = (f32x2){0.f, 0.f};
#pragma unroll
    for (int p = 0; p < 8; ++p) { v[p] -= m2; q2 += v[p] * v[p]; }
    const float rstd = __builtin_amdgcn_rsqf(wave_sum(q2[0] + q2[1], lane) * (1.0f / D) + LN_EPS); const f32x2 r2 = (f32x2){rstd, rstd};
#pragma unroll
    for (int hh = 0; hh < 4; ++hh) { const f32x4 g4 = *(LAS const f32x4*)(gb + hh * 256 + lane * 4), b4 = *(LAS const f32x4*)(gb + (4 + hh) * 256 + lane * 4);
        v[2 * hh] = v[2 * hh] * (r2 * (f32x2){g4[0], g4[1]}) + (f32x2){b4[0], b4[1]}; v[2 * hh + 1] = v[2 * hh + 1] * (r2 * (f32x2){g4[2], g4[3]}) + (f32x2){b4[2], b4[3]}; }
}
template <int NJ> __device__ __forceinline__ void row_dots2(const f32x2 (&v)[2][8], LAS const float* tab, int lane, float (&out)[2 * NJ]) {
#pragma unroll
    for (int j = 0; j < NJ; ++j) { f32x2 s0 = (f32x2){0.f, 0.f}, s1 = (f32x2){0.f, 0.f};
#pragma unroll
        for (int hh = 0; hh < 4; ++hh) { const f32x4 w = *(LAS const f32x4*)(tab + (j * 4 + hh) * 256 + lane * 4); const f32x2 w01 = (f32x2){w[0], w[1]}, w23 = (f32x2){w[2], w[3]};
            s0 += v[0][2 * hh] * w01; s0 += v[0][2 * hh + 1] * w23; s1 += v[1][2 * hh] * w01; s1 += v[1][2 * hh + 1] * w23; }
        out[j] = s0[0] + s0[1]; out[NJ + j] = s1[0] + s1[1]; }
}
__device__ __forceinline__ void store_row_bf16_2(bf16_t* row, int lane, const f32x2 (&v)[8]) {
    u32x4 a, b; a.x = pk2(v[0][0], v[0][1]); a.y = pk2(v[1][0], v[1][1]); a.z = pk2(v[2][0], v[2][1]); a.w = pk2(v[3][0], v[3][1]);
    b.x = pk2(v[4][0], v[4][1]); b.y = pk2(v[5][0], v[5][1]); b.z = pk2(v[6][0], v[6][1]); b.w = pk2(v[7][0], v[7][1]);
    *(u32x4*)(row + 8 * lane) = a; *(u32x4*)(row + 512 + 8 * lane) = b;
}
__device__ __forceinline__ void store_row_f32_2(float* row, int lane, const f32x2 (&v)[8]) {
#pragma unroll
    for (int j = 0; j < 2; ++j)
#pragma unroll
        for (int q = 0; q < 2; ++q) *(f32x4*)(row + 512 * j + 8 * lane + 4 * q) = (f32x4){v[4 * j + 2 * q][0], v[4 * j + 2 * q][1], v[4 * j + 2 * q + 1][0], v[4 * j + 2 * q + 1][1]};
}
__device__ __forceinline__ void p9_combine_ln(const Ctx& F, int l, bool dry) {
    bf16_t* X = (bf16_t*)(F.ws + WS_X); bf16_t* XO = dry ? (bf16_t*)(F.ws + WS_PRE) : X; float* FO = F.out; const unsigned char* YB = F.ws + WS_YB;
    float* GATES = (float*)(F.ws + WS_GATES); unsigned char* XF = F.ws + (dry ? WS_PRE + 128 * MiB - 64 * MiB : WS_XF);
    LAS float* wif = (LAS float*)F.lds;
    const bool lastl = (l == DEPTH - 1);
    LAS float* gb = (LAS float*)(F.lds + 32768);
    const int gw = F.wg * NWAVES + F.wave, NGW = F.G * NWAVES, npair = M / (2 * NGW);
    const bf16_t* PREp = (const bf16_t*)(F.ws + WS_PRE); LAS float* gm = gb + 2048;
    struct RawRows { u32x4 x[2][2]; u32x2 y[2][2][2]; f32x2 s[2]; };
    RawRows rawA, rawB;
#define P9_LOADS(it_, raw) do { _Pragma("unroll") for (int rr = 0; rr < 2; ++rr) { const size_t o_ = (size_t)(gw + NGW * (2 * (it_) + rr)) * D + 8 * F.lane; \
        raw.x[rr][0] = *(const u32x4*)(PREp + o_); raw.x[rr][1] = *(const u32x4*)(PREp + o_ + 512); raw.s[rr] = *(const f32x2*)(F.ws + WS_RE + (size_t)(gw + NGW * (2 * (it_) + rr)) * 8); \
        raw.y[rr][0][0] = *(const u32x2*)(YB + o_); raw.y[rr][0][1] = *(const u32x2*)(YB + o_ + 512); \
        raw.y[rr][1][0] = *(const u32x2*)(YB + (size_t)M * D + o_); raw.y[rr][1][1] = *(const u32x2*)(YB + (size_t)M * D + o_ + 512); } } while (0)
#define P9_XP(w_) ((f32x2){__uint_as_float((w_) << 16), __uint_as_float((w_) & 0xffff0000u)})
#define P9_COMB(dst, xw_, y0w_, y1w_, hi_, a2_, b2_) do { const f32x2 ya_ = __builtin_amdgcn_cvt_pk_f32_fp8((int)(y0w_), hi_), yb_ = __builtin_amdgcn_cvt_pk_f32_fp8((int)(y1w_), hi_); \
        dst = P9_XP(xw_) * (a2_) + ((ya_ + yb_) * (f32x2){1.0f / YB_SCALE, 1.0f / YB_SCALE} + (b2_)); } while (0)
#define P9_STEP(k_, raw) do { const int k = (k_); f32x2 v[2][8]; \
        _Pragma("unroll") for (int rr = 0; rr < 2; ++rr) \
            _Pragma("unroll") for (int j = 0; j < 2; ++j) { const u32x4 xw = raw.x[rr][j]; const u32x2 y0w = raw.y[rr][0][j], y1w = raw.y[rr][1][j]; \
                const float ar_ = ALPHA * raw.s[rr][1], mn_ = raw.s[rr][0]; f32x2 a2[4], b2[4]; \
                _Pragma("unroll") for (int hf = 0; hf < 2; ++hf) { const f32x4 g4 = *(LAS const f32x4*)(gm + (2 * j + hf) * 256 + F.lane * 4), c4 = *(LAS const f32x4*)(gm + (4 + 2 * j + hf) * 256 + F.lane * 4); \
                    a2[2 * hf] = (f32x2){g4[0], g4[1]} * ar_; a2[2 * hf + 1] = (f32x2){g4[2], g4[3]} * ar_; b2[2 * hf] = (f32x2){c4[0], c4[1]} - a2[2 * hf] * mn_; b2[2 * hf + 1] = (f32x2){c4[2], c4[3]} - a2[2 * hf + 1] * mn_; } \
                P9_COMB(v[rr][4 * j], xw.x, y0w.x, y1w.x, false, a2[0], b2[0]); P9_COMB(v[rr][4 * j + 1], xw.y, y0w.x, y1w.x, true, a2[1], b2[1]); \
                P9_COMB(v[rr][4 * j + 2], xw.z, y0w.y, y1w.y, false, a2[2], b2[2]); P9_COMB(v[rr][4 * j + 3], xw.w, y0w.y, y1w.y, true, a2[3], b2[3]); } \
        if (k + 2 < npair) P9_LOADS(k + 2, raw); \
        _Pragma("unroll") for (int rr = 0; rr < 2; ++rr) { const int m = gw + NGW * (2 * k + rr); ln_inplace_lds2(v[rr], gb, F.lane); \
            if (lastl) store_row_f32_2(FO + (size_t)m * D, F.lane, v[rr]); else { store_row_bf16_2(XO + (size_t)m * D, F.lane, v[rr]); \
                _Pragma("unroll") for (int j = 0; j < 2; ++j) { u32x2 f8; f8.x = pack4_fp8c((f32x4){v[rr][4 * j][0], v[rr][4 * j][1], v[rr][4 * j + 1][0], v[rr][4 * j + 1][1]}, 1.0f); f8.y = pack4_fp8c((f32x4){v[rr][4 * j + 2][0], v[rr][4 * j + 2][1], v[rr][4 * j + 3][0], v[rr][4 * j + 3][1]}, 1.0f); \
                    *(u32x2*)(XF + (size_t)m * D + 512 * j + 8 * F.lane) = f8; } } } \
        if (!lastl) { float part[16]; row_dots2<8>(v, wif, F.lane, part); \
            const float tot = reduce16(part, F.lane); \
            if ((F.lane & 3) == 0) { const int ix = idx16(F.lane), rr = ix >> 3, j = ix & 7; GATES[(size_t)(gw + NGW * (2 * k + rr)) * 8 + j] = tot + F.b_in[(size_t)(l + 1) * PIN + SRC_IF + j]; } } } while (0)
    P9_LOADS(0, rawA); P9_LOADS(1, rawB);
    if (!lastl) { const f32x4* src = (const f32x4*)(F.ws + WS_WIFP) + (size_t)(l + 1) * 2 * D;
#pragma unroll
        for (int j = 0; j < 4; ++j) *(LAS f32x4*)(wif + 4 * (F.tid + NTHR * j)) = src[F.tid + NTHR * j]; }
    for (int k = F.tid; k < D; k += NTHR) { gb[wperm_idx(0, k)] = F.ln_moe_g[(size_t)l * D + k]; gb[wperm_idx(1, k)] = F.ln_moe_b[(size_t)l * D + k]; }
    for (int k = F.tid; k < D; k += NTHR) { gm[wperm_idx(0, k)] = F.ln_mix_g[(size_t)l * D + k]; gm[wperm_idx(1, k)] = ALPHA * F.ln_mix_b[(size_t)l * D + k]; }
    __syncthreads();
    for (int it = 0; it < npair; it += 2) { P9_STEP(it, rawA); P9_STEP(it + 1, rawB); }
#undef P9_LOADS
#undef P9_XP
#undef P9_COMB
#undef P9_STEP
}

__global__ void __launch_bounds__(NTHR, 2) fwd(Args args) {
    extern __shared__ __attribute__((aligned(16))) unsigned char lds_raw[];
    Ctx F;
    F.lds = (LAS unsigned char*)lds_raw;
    F.tid = threadIdx.x; F.lane = F.tid & 63; F.wave = __builtin_amdgcn_readfirstlane(F.tid >> 6); F.G = gridDim.x; F.wg = blockIdx.x;
typedef unsigned long long u64x8 __attribute__((ext_vector_type(8)));
    typedef unsigned long long u64x2 __attribute__((ext_vector_type(2)));
#define PTRG(T, v) ((T)(GAS T)(v))
#define REFRESH() do { F.tid = opaque_tid(); F.lane = F.tid & 63; F.wave = __builtin_amdgcn_readfirstlane(F.tid >> 6); \
        u64x8 _a, _b; u64x2 _c; \
        asm volatile("s_load_dwordx16 %0, %3, 0x0\n\ts_load_dwordx16 %1, %3, 0x40\n\ts_load_dwordx4 %2, %3, 0x80\n\ts_waitcnt lgkmcnt(0)" : "=&s"(_a), "=&s"(_b), "=&s"(_c) : "s"(__builtin_amdgcn_kernarg_segment_ptr())); \
        F.x = PTRG(const float*, _a[0]); F.w_in = PTRG(const float*, _a[1]); F.b_in = PTRG(const float*, _a[2]); F.conv_w = PTRG(const float*, _a[3]); F.mh_g = PTRG(const float*, _a[4]); F.w_out = PTRG(const float*, _a[5]); \
        F.ln_mix_g = PTRG(const float*, _a[6]); F.ln_mix_b = PTRG(const float*, _a[7]); F.router_w = PTRG(const float*, _b[0]); F.router_b = PTRG(const float*, _b[1]); F.w_gate = PTRG(const float*, _b[2]); F.w_up = PTRG(const float*, _b[3]); \
        F.w_down = PTRG(const float*, _b[4]); F.ln_moe_g = PTRG(const float*, _b[5]); F.ln_moe_b = PTRG(const float*, _b[6]); F.out = PTRG(float*, _b[7]); F.ws = PTRG(unsigned char*, _c[0]); } while (0)
    F.x = args.in[0]; F.w_in = args.in[1]; F.b_in = args.in[2]; F.conv_w = args.in[3]; F.mh_g = args.in[4]; F.w_out = args.in[5]; F.ln_mix_g = args.in[6]; F.ln_mix_b = args.in[7];
    F.router_w = args.in[8]; F.router_b = args.in[9]; F.w_gate = args.in[10]; F.w_up = args.in[11]; F.w_down = args.in[12]; F.ln_moe_g = args.in[13]; F.ln_moe_b = args.in[14];
    F.out = args.out; F.ws = args.ws;
    for (int u = F.tid; u < (LDS_BYTES - MISC_OFF) / 4; u += NTHR) ((LAS unsigned*)(F.lds + MISC_OFF))[u] = 0u;
    __syncthreads();
    XcdBarrier bar; bar.bar = (unsigned*)(F.ws + WS_CTL) + CW_BAR + args.li * XCD_BAR_WORDS; bar.x = 0; bar.st = (volatile LAS unsigned*)(F.lds + MISC_OFF);
    const int lo = args.ph_lo, hi = args.ph_hi;
    if (hi - lo > 1) bar = xcd_barrier_post((unsigned*)(F.ws + WS_CTL) + CW_BAR + args.li * XCD_BAR_WORDS, (volatile LAS unsigned*)(F.lds + MISC_OFF));
#define IN(k) (lo <= (k) && (k) < hi)
#define SEAM(k) do { if (IN(k) && IN((k) + 1)) xcd_barrier(bar); } while (0)
    LAS const int* tab = (LAS const int*)(F.lds + MISC_OFF + 64);
    LAS int* toks = (LAS int*)(F.lds + TOK_OFF);

    if (EN(0) && IN(0))
#pragma unroll 1
    for (int rep = 0; rep < REPS(0); ++rep) { REFRESH(); p0_prologue(F); __syncthreads(); }
    SEAM(0);
    for (int l = 0; l < DEPTH; ++l) {
        const int pb = 1 + 9 * l;
        if (EN(1) && IN(pb + 0))
#pragma unroll 1
        for (int rep = 0; rep < REPS(1); ++rep) {
            REFRESH();
            pg8::DenseOrder S; S.nM = M / 256; S.nN = NP / 256; S.nwg = S.nM * S.nN; S.G = F.G; S.c = F.wg; S.lda = D / 2; S.K = D / 2; S.Bt = (const bf16_t*)(F.ws + WS_WIN) + (size_t)l * NP * (D / 2);
            { LAS float* bl = (LAS float*)(F.lds + BIAS_OFF); const float* bsrc = F.b_in + (size_t)l * PIN;
              for (int i = F.tid; i < NP; i += NTHR) bl[i] = bsrc[win_src_col(i)];
              __syncthreads(); }
            pg8::EpiInProj E{(bf16_t*)(F.ws + WS_P), F.ws + WS_CV, (LAS const float*)(F.lds + BIAS_OFF)};
            pg8::gemm_phase<pg8::EpiInProj, pg8::DenseOrder>(F.lds, (const bf16_t*)(F.ws + WS_XF), S, E);
        }
        SEAM(pb + 0);
        if (EN(2) && IN(pb + 1))
#pragma unroll 1
        for (int rep = 0; rep < REPS(2); ++rep) { REFRESH(); p2_local_conv(F, l); }
        SEAM(pb + 1);
        if (EN(3) && IN(pb + 2))
#pragma unroll 1
        for (int rep = 0; rep < REPS(3); ++rep) { REFRESH(); p3_scan(F); }
        SEAM(pb + 2);
        if (EN(4) && IN(pb + 3))
#pragma unroll 1
        for (int rep = 0; rep < REPS(4); ++rep) { REFRESH(); p4_mlstm_out(F, l); }
        SEAM(pb + 3);
        if (EN(5) && IN(pb + 4))
#pragma unroll 1
        for (int rep = 0; rep < REPS(5); ++rep) {
            REFRESH();
            pg8::DenseOrder S; S.nM = M / 256; S.nN = D / 256; S.nwg = S.nM * S.nN; S.G = F.G; S.c = F.wg; S.lda = D / 2; S.K = D / 2; S.Bt = (const bf16_t*)(F.ws + WS_WOUT) + (size_t)l * D * (D / 2);
            pg8::EpiOutProj E{(bf16_t*)(F.ws + WS_PRE), (const bf16_t*)(F.ws + WS_X)};
            pg8::gemm_phase<pg8::EpiOutProj, pg8::DenseOrder>(F.lds, (const bf16_t*)F.out, S, E);
        }
        SEAM(pb + 4);
        if (EN(6) && IN(pb + 5))
#pragma unroll 1
        for (int rep = REPS(6) - 1; rep >= 0; --rep) { REFRESH(); p6_ln_router(F, l, l + 4 * rep); __syncthreads(); }
        SEAM(pb + 5);
        if (EN(7) && IN(pb + 6))
#pragma unroll 1
        for (int pass = 0; pass < 2; ++pass) {
            REFRESH();
            if (pass == 0) moe_tables(F, l);
            const int nwg7 = __builtin_amdgcn_readfirstlane(tab[32]) * 4, R7 = nwg7 / F.G, L7 = nwg7 - R7 * F.G;
            if (pass == 0 || F.wg < L7) {
                pg8::MoeOrder<true> S; S.nM = tab[32]; S.nN = 4; S.nwg = nwg7; S.G = F.G; S.c = F.wg; S.lda = D / 2; S.K = D / 2; S.Bt = (const bf16_t*)(F.ws + WS_WGU) + (size_t)l * NE * 1024 * (D / 2); S.estride = (size_t)1024 * (D / 2); S.tab = tab; S.toks = toks;
                S.i0 = pass ? R7 : 0; S.ni = pass ? 1 : R7; S.L = 0; S.lmask = (LAS const unsigned*)(F.lds + MISC_OFF + 256); S.left = (unsigned*)(F.ws + WS_CTL) + CW_LEFT + l;
                const int* TL = (const int*)(F.ws + WS_TLIST);
                { int vals[MAXU / 2];
#pragma unroll
                  for (int j = 0; j < MAXU / 2; ++j) { pg8::Unit u{0, 0, 0, 0, 0}; const bool ok = S.next(2 * j + (F.tid >> 8), u); const int slot = u.rb * 256 + (F.tid & 255); const bool live = ok && slot < tab[u.e];
                      const int v = TL[live ? (size_t)u.e * M + slot : (size_t)0]; vals[j] = live ? (v >> 1) : 0; }
#pragma unroll
                  for (int j = 0; j < MAXU / 2; ++j) toks[(2 * j + (F.tid >> 8)) * 256 + (F.tid & 255)] = vals[j]; }
                __syncthreads();
                pg8::EpiGateUp E{F.ws + WS_HDN};
                pg8::gemm_phase<pg8::EpiGateUp, pg8::MoeOrder<true>>(F.lds, (const bf16_t*)((const unsigned char*)F.out + X1F_OFF), S, E);
                if (pass) {
                    VM_WAIT(); __syncthreads();
                    if (F.tid == 0) { __builtin_amdgcn_fence(__ATOMIC_RELEASE, "agent"); VM_WAIT(); (void)xb_add((unsigned*)(F.ws + WS_CTL) + CW_LEFT + l, 1u); }
                }
            }
            if (pass == 0) SEAM(pb + 6);
        }
        if (EN(8) && IN(pb + 7))
#pragma unroll 1
        for (int rep = 0; rep < REPS(8); ++rep) {
            REFRESH();
            if (MK_PER_PHASE) moe_tables(F, l);
            const int nwg7 = __builtin_amdgcn_readfirstlane(tab[32]) * 4, R7 = nwg7 / F.G, L7 = nwg7 - R7 * F.G;
            { LAS unsigned* lm = (LAS unsigned*)(F.lds + MISC_OFF + 256);
              __syncthreads();
              if (F.tid < 32) lm[F.tid] = 0u;
              __syncthreads();
              if (F.tid < L7) { pg8::Unit u{0, 0, 0, 0, 0}; pg8::static_unit(tab[32], 4, R7 * F.G + F.tid, u); atomicOr((unsigned*)(lm + (u.pm >> 5)), 1u << (u.pm & 31)); }
              __syncthreads(); }
            pg8::MoeOrder<false> S; S.nM = tab[32]; S.nN = 4; S.nwg = S.nM * 4; S.G = F.G; S.c = F.wg; S.lda = DFF / 2; S.K = DFF / 2; S.Bt = (const bf16_t*)(F.ws + WS_WDN) + (size_t)l * NE * D * (DFF / 2); S.estride = (size_t)D * (DFF / 2); S.tab = tab; S.toks = toks;
            S.i0 = 0; S.ni = 0; S.L = L7; S.lmask = (LAS const unsigned*)(F.lds + MISC_OFF + 256); S.left = (unsigned*)(F.ws + WS_CTL) + CW_LEFT + l;
            { const float* GLp = (const float*)(F.ws + WS_GLIST); LAS float* gts = (LAS float*)(F.lds + TOK_OFF);
              const int* TLp = (const int*)(F.ws + WS_TLIST); LAS int* dsts = (LAS int*)(F.lds + BIAS_OFF);
              float vals[MAXU / 2]; int dv[MAXU / 2];
#pragma unroll
              for (int j = 0; j < MAXU / 2; ++j) { pg8::Unit u{0, 0, 0, 0, 0}; const bool ok = S.next(2 * j + (F.tid >> 8), u); const int slot = u.rb * 256 + (F.tid & 255); const bool live = ok && slot < tab[u.e];
                  const float v = GLp[live ? (size_t)u.e * M + slot : (size_t)0]; const int d = TLp[live ? (size_t)u.e * M + slot : (size_t)0]; vals[j] = live ? v : 0.f; dv[j] = live ? d : -1; }
#pragma unroll
              for (int j = 0; j < MAXU / 2; ++j) { gts[(2 * j + (F.tid >> 8)) * 256 + (F.tid & 255)] = vals[j]; dsts[(2 * j + (F.tid >> 8)) * 256 + (F.tid & 255)] = dv[j]; }
              __syncthreads(); }
            pg8::EpiDown E{F.ws + WS_YB, (LAS const float*)(F.lds + TOK_OFF), (LAS const int*)(F.lds + BIAS_OFF)};
            pg8::gemm_phase<pg8::EpiDown, pg8::MoeOrder<false>>(F.lds, (const bf16_t*)(F.ws + WS_HDN), S, E);
        }
        SEAM(pb + 7);
        if (EN(9) && IN(pb + 8))
#pragma unroll 1
        for (int rep = REPS(9) - 1; rep >= 0; --rep) { REFRESH(); p9_combine_ln(F, l, rep != 0); __syncthreads(); }
        SEAM(pb + 8);
    }
#undef IN
#undef SEAM
}

extern "C" void kernel_launch(void* const* d_in, const int* in_sizes, int n_in, void* d_out, int out_size, void* d_ws, size_t ws_size, hipStream_t stream) {
    static int grid = 0;
    if (grid == 0) {
        if (n_in != 15 || in_sizes[0] != M * D || out_size != M * D || ws_size < WS_END) { fprintf(stderr, "kernel_launch: unexpected shapes (n_in %d, in0 %d, out %d, ws %zu)\n", n_in, n_in > 0 ? in_sizes[0] : -1, out_size, ws_size); grid = -1; return; }
        int dev = 0, cus = 0, per_cu = 0;
        if (hipGetDevice(&dev) != hipSuccess || hipDeviceGetAttribute(&cus, hipDeviceAttributeMultiprocessorCount, dev) != hipSuccess) { grid = -1; return; }
        if (hipFuncSetAttribute((const void*)fwd, hipFuncAttributeMaxDynamicSharedMemorySize, LDS_BYTES) != hipSuccess) { fprintf(stderr, "kernel_launch: hipFuncSetAttribute failed\n"); grid = -1; return; }
        if (hipOccupancyMaxActiveBlocksPerMultiprocessor(&per_cu, (const void*)fwd, NTHR, LDS_BYTES) != hipSuccess || per_cu < 1) fprintf(stderr, "kernel_launch: occupancy query says %d\n", per_cu);
        (void)hipGetLastError();
        grid = cus;
        if (grid > 256) grid = 256;
        if (grid != 256) { fprintf(stderr, "kernel_launch: %d CUs: this kernel is sized for 256\n", grid); grid = -1; return; }
    }
    if (grid < 0) return;
    if (hipMemsetAsync((char*)d_ws + WS_CTL, 0, CTL_ZERO_BYTES, stream) != hipSuccess) return;
    Args a{};
    for (int i = 0; i < 15; ++i) a.in[i] = (const float*)d_in[i];
    a.out = (float*)d_out; a.ws = (unsigned char*)d_ws; a.pad = 0;
#if MK_PER_PHASE
    for (int p = 0; p < NPHASE; ++p) { a.ph_lo = p; a.ph_hi = p + 1; a.li = 0; hipLaunchKernelGGL(fwd, dim3(grid), dim3(NTHR), LDS_BYTES, stream, a); }
#else
    a.ph_lo = 0; a.ph_hi = NPHASE; a.li = 0;
    hipLaunchKernelGGL(fwd, dim3(grid), dim3(NTHR), LDS_BYTES, stream, a);
#endif
}
```

```cpp
#include <hip/hip_runtime.h>
#include <cstdio>
#include <cstdint>

#ifndef MK_PER_PHASE
#define MK_PER_PHASE 0
#endif
#ifndef PH_MASK
#define PH_MASK 0x3ff
#endif
#define EN(k) (((PH_MASK) >> (k)) & 1)
#ifndef REP_MASK
#define REP_MASK 0
#endif
#define REPS(k) (1 + (((REP_MASK) >> (k)) & 1))

#define LAS __attribute__((address_space(3)))
#define GAS __attribute__((address_space(1)))
typedef unsigned short bf16_t;
typedef short bf16x8 __attribute__((ext_vector_type(8)));
typedef float f32x4 __attribute__((ext_vector_type(4)));
typedef float f32x2 __attribute__((ext_vector_type(2)));
typedef int i32x8v __attribute__((ext_vector_type(8)));
typedef float f32x8v __attribute__((ext_vector_type(8)));
typedef unsigned u32x4 __attribute__((ext_vector_type(4)));
typedef unsigned u32x2 __attribute__((ext_vector_type(2)));
#define RLX_AGENT __ATOMIC_RELAXED, __HIP_MEMORY_SCOPE_AGENT
#define LDS_WAIT() asm volatile("s_waitcnt lgkmcnt(0)" ::: "memory")
#define VM_WAIT() asm volatile("s_waitcnt vmcnt(0)" ::: "memory")

constexpr int D = 1024, NB = 8, SEQ = 8192, M = NB * SEQ, DEPTH = 4;
constexpr int NH = 4, DH = 128, CHK = 128, NCH = SEQ / CHK;
constexpr int PIN = 3592;
constexpr int NP = 3584;
constexpr int NPB = 1024;
constexpr int PQ = 0, PK = 512;
constexpr int NCV = 3072;
constexpr int CGB = 0, CU = 512, CO = 1024, CVV = 1536, CQ = 2048, CK = 2560;
__host__ __device__ __forceinline__ int win_src_col(int n) {
    const int grp = n >> 9;
    if (grp >= 5) { const int w = n & 255, t = (n - 2560) >> 8; return (((w >> 5) & 1) ? 3080 : 2568) + t * 128 + (w >> 6) * 32 + (w & 31); }
    return (grp == 0 ? 0 : grp == 1 ? 2056 : grp == 2 ? 512 : grp == 3 ? 1024 : 1536) + (n & 511);
}
constexpr int SRC_IF = 2048;
constexpr int NE = 16, DFF = 512;
constexpr int MAXROWS = 2 * M + NE * 256;
constexpr float ALPHA = 1.6817928305074290f, LN_EPS = 1e-5f;
constexpr float YB_SCALE = 8.0f;
constexpr int NWAVES = 8, NTHR = 512;
constexpr int NPHASE = 1 + DEPTH * 9;

constexpr size_t MiB = (size_t)1 << 20;
constexpr size_t WS_CTL = 0, CTL_ZERO_BYTES = MK_PER_PHASE ? 2 * MiB : 32768;
constexpr size_t WS_RFB = 2 * MiB;
constexpr size_t WS_WIFP = 2 * MiB + 65536;
constexpr size_t WS_GATES = 3 * MiB;
constexpr size_t WS_AA = 5 * MiB;
constexpr size_t WS_BB = 6 * MiB;
constexpr size_t WS_NL = 7 * MiB;
constexpr size_t WS_ML = 8 * MiB;
constexpr size_t WS_GC = 8 * MiB + 8192;
constexpr size_t WS_MST = 8 * MiB + 16384;
constexpr size_t WS_RE = 9 * MiB;
constexpr size_t WS_RS = 9 * MiB + 512 * 1024;
constexpr size_t WS_NST = 10 * MiB;
constexpr size_t WS_TLIST = 11 * MiB;
constexpr size_t WS_GLIST = 15 * MiB;
constexpr size_t WS_PM = 19 * MiB;
constexpr size_t WS_WIN = 20 * MiB;
constexpr size_t WS_WOUT = 48 * MiB;
constexpr size_t WS_WGU = 56 * MiB;
constexpr size_t WS_WDN = 184 * MiB;
constexpr size_t WS_X = 248 * MiB;
constexpr size_t WS_CS = 376 * MiB;
constexpr size_t WS_PRE = WS_CS;
constexpr size_t WS_P = 504 * MiB;
constexpr size_t WS_CV = 504 * MiB + 128 * MiB;
constexpr size_t WS_XF = WS_P;
constexpr size_t WS_HDN = WS_P;
constexpr size_t WS_YB = 640 * MiB;
constexpr size_t WS_END = 952 * MiB;
constexpr size_t X1F_OFF = 160 * MiB;
constexpr size_t CSB_OFF = 128 * MiB;
static_assert(WS_CV + (size_t)M * NCV <= WS_END, "ws map: CV");
static_assert(WS_HDN + (size_t)MAXROWS * DFF * 2 <= WS_YB && WS_YB + (size_t)MAXROWS * D * 2 <= WS_END && WS_P + (size_t)M * NP * 2 <= WS_END, "ws map");
constexpr int CW_CNT = 64;
constexpr int CW_LEFT = 1024;
constexpr int CW_BAR = 4096;
constexpr int SCR_BYTES = 131072;
constexpr int MISC_OFF = SCR_BYTES;
constexpr int TOK_OFF = MISC_OFF + 1024, MAXU = 12;
constexpr int BIAS_OFF = 147456;
constexpr int LDS_BYTES = 163840;
static_assert(TOK_OFF + MAXU * 256 * 4 <= BIAS_OFF && BIAS_OFF + NP * 4 <= LDS_BYTES, "lds map");

__device__ __forceinline__ int opaque_tid() { int t = threadIdx.x; asm volatile("" : "+v"(t)); return t; }
__device__ __forceinline__ float bf2f(unsigned b) { return __uint_as_float(b << 16); }
__device__ __forceinline__ unsigned pk2(float lo, float hi) { unsigned r; asm volatile("v_cvt_pk_bf16_f32 %0, %1, %2" : "=v"(r) : "v"(lo), "v"(hi)); return r; }
__device__ __forceinline__ unsigned pack4_fp8c(const f32x4 v, float scale) {
    const f32x4 sv = v * scale;
    const float a = __builtin_amdgcn_fmed3f(sv[0], -400.f, 400.f), b = __builtin_amdgcn_fmed3f(sv[1], -400.f, 400.f), c = __builtin_amdgcn_fmed3f(sv[2], -400.f, 400.f), d = __builtin_amdgcn_fmed3f(sv[3], -400.f, 400.f);
    int w = __builtin_amdgcn_cvt_pk_fp8_f32(a, b, 0, false); w = __builtin_amdgcn_cvt_pk_fp8_f32(c, d, w, true); return (unsigned)w; }
__device__ __forceinline__ f32x4 unpack4_fp8(unsigned w) { const f32x2 lo = __builtin_amdgcn_cvt_pk_f32_fp8((int)w, false), hi = __builtin_amdgcn_cvt_pk_f32_fp8((int)w, true); return (f32x4){lo[0], lo[1], hi[0], hi[1]}; }
__device__ __forceinline__ u32x4 fp8x8_to_bf16x8(const u32x2 w) { const f32x4 a = unpack4_fp8(w.x), b = unpack4_fp8(w.y); u32x4 o; o.x = pk2(a[0], a[1]); o.y = pk2(a[2], a[3]); o.z = pk2(b[0], b[1]); o.w = pk2(b[2], b[3]); return o; }
__device__ __forceinline__ u32x4 widen_fp8_pair(const u32x2 a, const u32x2 b) {
    const auto r0 = __builtin_amdgcn_permlane16_swap(a.x, b.x, false, false); const auto r1 = __builtin_amdgcn_permlane16_swap(a.y, b.y, false, false);
    u32x4 w; w.x = r0[0]; w.y = r1[0]; w.z = r0[1]; w.w = r1[1]; return w; }
__device__ __forceinline__ void lane_row_transpose4(unsigned (&x)[4]) {
    const auto a = __builtin_amdgcn_permlane16_swap(x[0], x[1], false, false), b = __builtin_amdgcn_permlane16_swap(x[2], x[3], false, false);
    const auto c = __builtin_amdgcn_permlane32_swap(a[0], b[0], false, false), d = __builtin_amdgcn_permlane32_swap(a[1], b[1], false, false);
    x[0] = c[0]; x[1] = d[0]; x[2] = c[1]; x[3] = d[1];
}
constexpr float WGU_SCALE = 32.0f, WDN_SCALE = 64.0f, H_SCALE = 4.0f, WOUT_SCALE = 64.0f, Y_SCALE = 8.0f, WIN_SCALE = 32.0f;
constexpr float CL_SCALE = 16.0f, CS_SCALE = 8.0f;
#define MFMA_DRAIN() do { __builtin_amdgcn_sched_barrier(0); asm volatile("s_nop 15\n\ts_nop 15" ::: "memory"); __builtin_amdgcn_sched_barrier(0); } while (0)
__device__ __forceinline__ void unpack8(const u32x4 w, float (&f)[8]) {
    f[0] = __uint_as_float(w.x << 16); f[1] = __uint_as_float(w.x & 0xffff0000u); f[2] = __uint_as_float(w.y << 16); f[3] = __uint_as_float(w.y & 0xffff0000u);
    f[4] = __uint_as_float(w.z << 16); f[5] = __uint_as_float(w.z & 0xffff0000u); f[6] = __uint_as_float(w.w << 16); f[7] = __uint_as_float(w.w & 0xffff0000u);
}
__device__ __forceinline__ u32x4 pack8(const float (&f)[8]) { u32x4 w; w.x = pk2(f[0], f[1]); w.y = pk2(f[2], f[3]); w.z = pk2(f[4], f[5]); w.w = pk2(f[6], f[7]); return w; }
__device__ __forceinline__ float shx(float v, int mask, int lane) { return __int_as_float(__builtin_amdgcn_ds_bpermute((lane ^ mask) << 2, __float_as_int(v))); }
__device__ __forceinline__ float shup(float v, int d, int lane) { return __int_as_float(__builtin_amdgcn_ds_bpermute((lane - d) << 2, __float_as_int(v))); }
__device__ __forceinline__ float rdlane(float v, int src) { return __int_as_float(__builtin_amdgcn_readlane(__float_as_int(v), src)); }
template <int CTRL> __device__ __forceinline__ float dpp_mov(float v) { return __int_as_float(__builtin_amdgcn_update_dpp(0, __float_as_int(v), CTRL, 0xF, 0xF, true)); }
__device__ __forceinline__ float row_sum16(float v) { v += dpp_mov<0xB1>(v); v += dpp_mov<0x4E>(v); v += dpp_mov<0x141>(v); v += dpp_mov<0x140>(v); return v; }
__device__ __forceinline__ float wave_sum(float v, int) { v = row_sum16(v); return (rdlane(v, 0) + rdlane(v, 16)) + (rdlane(v, 32) + rdlane(v, 48)); }
__device__ __forceinline__ float sum_rows4(float v) {
    const auto a = __builtin_amdgcn_permlane32_swap(__float_as_uint(v), __float_as_uint(v), false, false); v = __uint_as_float(a[0]) + __uint_as_float(a[1]);
    const auto b = __builtin_amdgcn_permlane16_swap(__float_as_uint(v), __float_as_uint(v), false, false); return __uint_as_float(b[0]) + __uint_as_float(b[1]);
}
__device__ __forceinline__ float wave_max(float v, int lane) {
#pragma unroll
    for (int o = 1; o < 64; o <<= 1) v = fmaxf(v, shx(v, o, lane));
    return v;
}
__device__ __forceinline__ float sigmoidf_(float x) { return __builtin_amdgcn_rcpf(1.0f + __expf(-x)); }

#define XB_TMO      128
#define XB_XCNT(j)  (256  + 64 * (j))
#define XB_XSUB(j)  (1280 + 64 * (j))
#define XB_XGEN(j)  (2304 + 64 * (j))
#define XB_TOP      3328
#define XB_TOPGEN   3392
#define XCD_BAR_WORDS 3456
#define XB_SPIN_CAP (1u << 18)
static_assert(MK_PER_PHASE || (size_t)(CW_BAR + XCD_BAR_WORDS) * 4 <= CTL_ZERO_BYTES, "control words");
__device__ __forceinline__ unsigned xb_ld(unsigned* p)              { return __hip_atomic_load(p, __ATOMIC_RELAXED, __HIP_MEMORY_SCOPE_AGENT); }
__device__ __forceinline__ unsigned xb_add(unsigned* p, unsigned v) { return __hip_atomic_fetch_add(p, v, __ATOMIC_RELAXED, __HIP_MEMORY_SCOPE_AGENT); }
__device__ __forceinline__ unsigned xb_xcc_id() { return (unsigned)__builtin_amdgcn_s_getreg((3 << 11) | 20) & 0xFu; }
#define XB_SPIN(cond, bar) do { unsigned _sp = 0; while (cond) { __builtin_amdgcn_s_sleep(1); \
    if ((++_sp & 255u) == 0u) { if (xb_ld(&(bar)[XB_TMO])) break; if (_sp > XB_SPIN_CAP) { atomicAdd(&(bar)[XB_TMO], 1u); break; } } } } while (0)
struct XcdBarrier { unsigned* bar; unsigned x; volatile LAS unsigned* st; };
__device__ __forceinline__ XcdBarrier xcd_barrier_post(unsigned* bar, volatile LAS unsigned* st) {
    XcdBarrier b; b.bar = bar; b.x = xb_xcc_id(); b.st = st;
    if (threadIdx.x == 0) (void)xb_add(&bar[XB_XCNT(b.x)], 1u);
    return b;
}
__device__ __forceinline__ void xcd_barrier_complete(unsigned* bar, unsigned x, unsigned& nloc, unsigned& nx) {
    const unsigned G = gridDim.x * gridDim.y * gridDim.z;
    unsigned sum, cnt, mine, sp = 0u;
    for (;;) {
        sum = 0u; cnt = 0u; mine = 0u;
#pragma unroll
        for (unsigned j = 0; j < 16; ++j) { const unsigned c = xb_ld(&bar[XB_XCNT(j)]); sum += c; cnt += (c > 0u) ? 1u : 0u; mine = (j == x) ? c : mine; }
        if (sum == G) break;
        __builtin_amdgcn_s_sleep(1);
        if ((++sp & 255u) == 0u) { if (xb_ld(&bar[XB_TMO])) break; if (sp > XB_SPIN_CAP) { atomicAdd(&bar[XB_TMO], 1u); break; } }
    }
    nloc = mine > 0u ? mine : 1u; nx = cnt > 0u ? cnt : 1u;
}
__device__ __forceinline__ void xcd_barrier(const XcdBarrier& b) {
    asm volatile("s_waitcnt vmcnt(0)" ::: "memory");
    __syncthreads();
    if (threadIdx.x == 0) {
        unsigned* bar = b.bar;
        __builtin_amdgcn_s_waitcnt(0);
        unsigned nloc = b.st[0], nx = b.st[1];
        if (nloc == 0u) { xcd_barrier_complete(bar, b.x, nloc, nx); b.st[0] = nloc; b.st[1] = nx; }
        const unsigned old = xb_add(&bar[XB_XSUB(b.x)], 1u);
        const unsigned gen = old / nloc;
        if (old + 1u == (gen + 1u) * nloc) {
            __builtin_amdgcn_fence(__ATOMIC_RELEASE, "agent");
            asm volatile("s_waitcnt vmcnt(0)" ::: "memory");
            const unsigned og = xb_add(&bar[XB_TOP], 1u);
            const unsigned tg = og / nx;
            if (og + 1u == (tg + 1u) * nx) xb_add(&bar[XB_TOPGEN], 1u);
            else XB_SPIN(xb_ld(&bar[XB_TOPGEN]) == tg, bar);
            __builtin_amdgcn_fence(__ATOMIC_ACQUIRE, "agent");
            xb_add(&bar[XB_XGEN(b.x)], 1u);
            asm volatile("s_waitcnt vmcnt(0)" ::: "memory");
        } else {
            XB_SPIN(xb_ld(&bar[XB_XGEN(b.x)]) == gen, bar);
            __builtin_amdgcn_fence(__ATOMIC_ACQUIRE, "agent");
            asm volatile("s_waitcnt vmcnt(0)" ::: "memory");
        }
    }
    __syncthreads();
}

namespace pg8 {
constexpr int BM = 256, BK = 64, HALF = 128, HTB = HALF * BK * 2, STAGE_BYTES = 8 * HTB, NXCD = 8, WGM = 4;
__host__ __device__ __forceinline__ int lds_byte(int r, int c) { const int st = (r >> 4) * 2 + (c >> 5), rr = r & 15, cc = c & 31, ob = rr * 64 + cc * 2; return st * 1024 + (ob ^ (((ob >> 9) & 1) << 5)); }
__host__ __device__ __forceinline__ void stage_rc(int b, int& R, int& C) { const int st = b / 1024, sb = b % 1024, swz = sb ^ (((sb >> 9) & 1) << 5); R = (st >> 1) * 16 + swz / 64; C = (st & 1) * 32 + (swz % 64) / 2; }
__host__ __device__ __forceinline__ int perm32(int rho) { const int n = rho >> 4, i = rho & 15; return 8 * (i >> 2) + 4 * n + (i & 3); }

struct Unit { int pm, pn, e, rb, ui; };

__device__ __forceinline__ void static_unit(int nM, int nN, int wgid0, Unit& u, int rot = 0) {
    const int nwg = nM * nN; int wgid = wgid0;
    { const int q = nwg / NXCD, r = nwg % NXCD, xcd = wgid % NXCD; int off = wgid / NXCD; const int qs = q + (xcd < r ? 1 : 0);
      if (rot) { off += rot; off -= (off >= qs) ? qs : 0; }
      wgid = (xcd < r ? xcd * (q + 1) : r * (q + 1) + (xcd - r) * q) + off; }
    const int nig = WGM * nN, gid = wgid / nig, fm = gid * WGM, gsz = (nM - fm) < WGM ? (nM - fm) : WGM;
    u.pm = fm + ((wgid % nig) % gsz); u.pn = (wgid % nig) / gsz; u.e = 0; u.rb = 0;
}
struct DenseOrder {
    static constexpr bool DENSE_A = true;
    int nM, nN, nwg, G, c, lda, K; const bf16_t* Bt;
    __device__ __forceinline__ bool next(int i, Unit& u) const { const long L = (long)i * G + c; if (L >= nwg) return false; static_unit(nM, nN, (int)L, u); u.ui = i; return true; }
    __device__ __forceinline__ void a_offsets(const Unit& u, int, unsigned (&off)[2][2]) const {
        const int tid = opaque_tid();
#pragma unroll
        for (int i = 0; i < 2; ++i) { int R, C; stage_rc(tid * 16 + i * 8192, R, C);
#pragma unroll
            for (int h = 0; h < 2; ++h) off[h][i] = (unsigned)((u.pm * BM + h * HALF + R) * lda + C) * 2u; }
    }
    __device__ __forceinline__ const char* b_tile(const Unit& u) const { return (const char*)(Bt + (size_t)u.pn * BM * K); }
};
constexpr int MOE_ROT = 16;
template <bool GATHER> struct MoeOrder {
    static constexpr bool DENSE_A = !GATHER;
    int nM, nN, nwg, G, c, lda, K; const bf16_t* Bt  ; size_t estride; LAS const int* tab; LAS const int* toks;
    int i0, ni, L; LAS const unsigned* lmask; unsigned* left;
    __device__ __forceinline__ bool next(int i, Unit& u) const {
        int id;
        if (GATHER) { if (i >= ni) return false; id = (i + i0) * G + c; if (id >= nwg) return false; static_unit(nM, nN, id, u); }
        else { const int v = (i + (c < L ? 2 : 0)) * G + c; const int mn = (v < G ? v : v - G) < L ? (v < G ? v : v - G) : L; const int resv = v < G ? mn : v < 2 * G ? L + mn : 2 * L;
               id = v - resv; if (id >= nwg) return false; static_unit(nM, nN, id, u, MOE_ROT); }
        u.ui = i;
        int e = 0;
#pragma unroll
        for (int q = 1; q < 16; ++q) e += (u.pm >= tab[16 + q]) ? 1 : 0;
        e = __builtin_amdgcn_readfirstlane(e); u.e = e; u.rb = __builtin_amdgcn_readfirstlane(u.pm - tab[16 + e]); return true;
    }
    __device__ __forceinline__ void a_offsets(const Unit& u, int ui, unsigned (&off)[2][2]) const {
        const int tid = opaque_tid();
        if (!GATHER) { if ((lmask[u.pm >> 5] >> (u.pm & 31)) & 1u) {
            unsigned sp = 0; while (xb_ld(left) < (unsigned)L && ++sp < XB_SPIN_CAP) __builtin_amdgcn_s_sleep(1);
            __builtin_amdgcn_fence(__ATOMIC_ACQUIRE, "agent"); } }
#pragma unroll
        for (int i = 0; i < 2; ++i) { int R, C; stage_rc(tid * 16 + i * 8192, R, C);
#pragma unroll
            for (int h = 0; h < 2; ++h) {
                if (GATHER) off[h][i] = (unsigned)(toks[ui * 256 + h * HALF + R] * lda + C) * 2u;
                else off[h][i] = (unsigned)((u.pm * BM + h * HALF + R) * lda + C) * 2u; } }
    }
    __device__ __forceinline__ const char* b_tile(const Unit& u) const { return (const char*)(Bt + (size_t)u.e * estride + (size_t)u.pn * BM * K); }
};

__device__ __forceinline__ unsigned cvt_pk_bf16(float lo, float hi) { unsigned r; asm volatile("v_cvt_pk_bf16_f32 %0, %1, %2" : "=v"(r) : "v"(lo), "v"(hi)); return r; }

struct EpiInProj {
    static constexpr bool PEEL = true; static constexpr bool FP8 = true; static constexpr bool PERM = true; static constexpr int NVM = 8;
    bf16_t* O; unsigned char* O8; LAS const float* bias_lds;
    __device__ __forceinline__ void operator()(f32x4 (&acc)[2][2][4][2], const Unit& u, int wr, int wc, int fr, int fq) const {
        const int row0 = u.pm * BM + wr * 64 + fr, cl = wc * 64 + 8 * fq, grp = u.pn >> 1, hc = (u.pn & 1) * BM + cl;
        LAS const float* bias = bias_lds + u.pn * BM;
#pragma unroll
        for (int bj = 0; bj < 2; ++bj)
#pragma unroll
            for (int n = 0; n < 2; ++n) { const f32x4 bv = *(LAS const f32x4*)(bias + cl + bj * 32 + 4 * n);
#pragma unroll
                for (int ai = 0; ai < 2; ++ai)
#pragma unroll
                    for (int m = 0; m < 4; ++m) acc[ai][bj][m][n] = acc[ai][bj][m][n] * (1.0f / WIN_SCALE) + bv; }
        if (grp >= 5) {
            const int c8 = CU + (u.pn - 10) * HALF + wc * 32 + 8 * fq;
#pragma unroll
            for (int ai = 0; ai < 2; ++ai)
#pragma unroll
                for (int m = 0; m < 4; ++m) { u32x2 a; a.x = pack4_fp8c(acc[ai][0][m][0] * acc[ai][1][m][0], 1.0f); a.y = pack4_fp8c(acc[ai][0][m][1] * acc[ai][1][m][1], 1.0f);
                    *(u32x2*)(O8 + (size_t)(row0 + ai * HALF + m * 16) * NCV + c8) = a; }
        } else {
            const int c8 = (grp == 0 ? CQ : grp == 1 ? CGB : grp == 2 ? CK : grp == 3 ? CVV : CO) + hc;
#pragma unroll
            for (int ai = 0; ai < 2; ++ai)
#pragma unroll
                for (int m = 0; m < 4; ++m) { unsigned char* rowp = O8 + (size_t)(row0 + ai * HALF + m * 16) * NCV + (c8 - 8 * fq) + (fq & 1) * 32 + 8 * (fq & ~1);
                    u32x2 a, b; a.x = pack4_fp8c(acc[ai][0][m][0], 1.0f); a.y = pack4_fp8c(acc[ai][0][m][1], 1.0f); b.x = pack4_fp8c(acc[ai][1][m][0], 1.0f); b.y = pack4_fp8c(acc[ai][1][m][1], 1.0f);
                    *(u32x4*)rowp = widen_fp8_pair(a, b); }
        }
    }
};
struct EpiOutProj {
    static constexpr bool PEEL = true; static constexpr bool FP8 = true; static constexpr bool PERM = true; static constexpr int NVM = 16;
    bf16_t* O; const bf16_t* X;
    __device__ __forceinline__ void operator()(const f32x4 (&acc)[2][2][4][2], const Unit& u, int wr, int wc, int fr, int fq) const {
        const int row0 = u.pm * BM + wr * 64 + fr, col0 = u.pn * BM + wc * 64 + 8 * fq;
        constexpr float IS = 1.0f / (Y_SCALE * WOUT_SCALE);
        u32x4 xr[2][4][2];
#pragma unroll
        for (int ai = 0; ai < 2; ++ai)
#pragma unroll
            for (int m = 0; m < 4; ++m)
#pragma unroll
                for (int bj = 0; bj < 2; ++bj) xr[ai][m][bj] = *(const u32x4*)(X + (size_t)(row0 + ai * HALF + m * 16) * D + col0 + bj * 32);
#pragma unroll
        for (int ai = 0; ai < 2; ++ai)
#pragma unroll
            for (int m = 0; m < 4; ++m)
#pragma unroll
                for (int bj = 0; bj < 2; ++bj) asm volatile("" : "+v"(xr[ai][m][bj]));
#pragma unroll
        for (int ai = 0; ai < 2; ++ai)
#pragma unroll
            for (int m = 0; m < 4; ++m) { const size_t off = (size_t)(row0 + ai * HALF + m * 16) * D + col0;
#pragma unroll
                for (int bj = 0; bj < 2; ++bj) { float xf[8]; unpack8(xr[ai][m][bj], xf);
                    const f32x4 a0 = acc[ai][bj][m][0], a1 = acc[ai][bj][m][1];
                    u32x4 w; w.x = cvt_pk_bf16(a0[0] * IS + ALPHA * xf[0], a0[1] * IS + ALPHA * xf[1]); w.y = cvt_pk_bf16(a0[2] * IS + ALPHA * xf[2], a0[3] * IS + ALPHA * xf[3]);
                    w.z = cvt_pk_bf16(a1[0] * IS + ALPHA * xf[4], a1[1] * IS + ALPHA * xf[5]); w.w = cvt_pk_bf16(a1[2] * IS + ALPHA * xf[6], a1[3] * IS + ALPHA * xf[7]);
                    *(u32x4*)(O + off + bj * 32) = w; } }
    }
};
struct EpiGateUp {
    static constexpr bool PEEL = true; static constexpr bool FP8 = true; static constexpr bool PERM = true; static constexpr int NVM = 8;
    unsigned char* O;
    __device__ __forceinline__ void operator()(const f32x4 (&acc)[2][2][4][2], const Unit& u, int wr, int wc, int fr, int fq) const {
        const int row0 = u.pm * BM + wr * 64 + fr, col0 = u.pn * HALF + wc * 32 + 8 * fq;
        constexpr float TS = -1.4426950408889634f / WGU_SCALE, HS = H_SCALE / (WGU_SCALE * WGU_SCALE);
#pragma unroll
        for (int ai = 0; ai < 2; ++ai)
#pragma unroll
            for (int m = 0; m < 4; ++m) { u32x2 hw;
#pragma unroll
                for (int n = 0; n < 2; ++n) { const f32x4 g = acc[ai][0][m][n], up = acc[ai][1][m][n];
                    const f32x4 t4 = g * TS; const f32x4 e4 = (f32x4){__builtin_amdgcn_exp2f(t4[0]), __builtin_amdgcn_exp2f(t4[1]), __builtin_amdgcn_exp2f(t4[2]), __builtin_amdgcn_exp2f(t4[3])} + 1.0f;
                    const f32x4 r4 = (f32x4){__builtin_amdgcn_rcpf(e4[0]), __builtin_amdgcn_rcpf(e4[1]), __builtin_amdgcn_rcpf(e4[2]), __builtin_amdgcn_rcpf(e4[3])};
                    const unsigned pw = pack4_fp8c((g * up) * r4, HS); if (n == 0) hw.x = pw; else hw.y = pw; }
                *(u32x2*)(O + (size_t)(row0 + ai * HALF + m * 16) * DFF + col0) = hw; }
    }
};
struct EpiDown {
    static constexpr bool PEEL = false; static constexpr bool FP8 = true; static constexpr bool PERM = true; static constexpr int NVM = 8;
    unsigned char* O; LAS const float* gates; LAS const int* dsts;
    __device__ __forceinline__ void operator()(const f32x4 (&acc)[2][2][4][2], const Unit& u, int wr, int wc, int fr, int fq) const {
        const int rl0 = wr * 64 + fr, col0 = u.pn * BM + wc * 64 + 8 * fq;
#pragma unroll
        for (int ai = 0; ai < 2; ++ai)
#pragma unroll
            for (int m = 0; m < 4; ++m) { const int rl = rl0 + ai * HALF + m * 16;
                const float g = gates[u.ui * 256 + rl] * (YB_SCALE / (H_SCALE * WDN_SCALE)); const int d = dsts[u.ui * 256 + rl];
                u32x2 a, b; a.x = pack4_fp8c(acc[ai][0][m][0], g); a.y = pack4_fp8c(acc[ai][0][m][1], g); b.x = pack4_fp8c(acc[ai][1][m][0], g); b.y = pack4_fp8c(acc[ai][1][m][1], g);
                const u32x4 w = widen_fp8_pair(a, b);
                unsigned char* rowp = O + (unsigned)((d < 0 ? 2 * M : (d & 1) * M + (d >> 1)) * D + (col0 - 8 * fq) + (fq & 1) * 32 + 8 * (fq & ~1));
                *(u32x4*)rowp = w; }
    }
};

template <class Epi, class Sched, bool ALIGN = true>
__device__ __forceinline__ void gemm_phase(LAS unsigned char* lds, const bf16_t* Aptr, const Sched& S, const Epi& E) {
    const int tid = opaque_tid(), wid = __builtin_amdgcn_readfirstlane(tid >> 6), lane = tid & 63, wr = wid >> 2, wc = wid & 3, fr = lane & 15, fq = lane >> 4;
    const int K = S.K, nt = K / BK;
    unsigned voffB[2];
#pragma unroll
    for (int i = 0; i < 2; ++i) { int R, C; stage_rc(tid * 16 + i * 8192, R, C); const int Rb = 64 * (R >> 5) + perm32(R & 31); voffB[i] = (unsigned)(Rb * K + C) * 2u; }
    const size_t kstep = (size_t)(BK * 2);
    const size_t hstep = (size_t)32 * K * 2;
    const unsigned ldsw = (unsigned)wid * 1024u;
    const int aoff = lds_byte(wr * 64 + fr, fq * 8), boff = lds_byte(wc * 32 + fr, fq * 8);
    const int aoff8 = lds_byte(wr * 64 + fr, (fq & 1) * 16) + (fq >> 1) * 1024, boff8 = lds_byte(wc * 32 + fr, (fq & 1) * 16) + (fq >> 1) * 1024;
    const char* Abase = (const char*)Aptr; const size_t ahalf = (size_t)HALF * S.lda * 2;
#define PG8_SA(b, h) (((b) * 2 + (h)) * HTB)
#define PG8_SB(b, h) ((4 + (b) * 2 + (h)) * HTB)
#define PG8_STAGE(bufoff, gbase, voff) do { _Pragma("unroll") for (int _i = 0; _i < 2; ++_i) \
        __builtin_amdgcn_global_load_lds((const unsigned*)((const char*)(gbase) + (voff)[_i]), (LAS unsigned*)(lds + (bufoff) + ldsw + _i * 8192), 16, 0, 0); } while (0)
#define PG8_STAGEA(bufoff, kb, off) PG8_STAGE(bufoff, Abase + (kb), off)
#define PG8_STAGEA1(bufoff, kb) do { if (Sched::DENSE_A) PG8_STAGE(bufoff, Abase + (kb) + ahalf, offC[0]); else PG8_STAGE(bufoff, Abase + (kb), offC[1]); } while (0)
typedef int i32x4v_ __attribute__((ext_vector_type(4)));
#define PG8_CAT8(x0_, x1_) __builtin_shufflevector(__builtin_bit_cast(i32x4v_, x0_), __builtin_bit_cast(i32x4v_, x1_), 0, 1, 2, 3, 4, 5, 6, 7)
#define PG8_LDA(dst, b, h) do { if (Epi::FP8) { _Pragma("unroll") for (int m = 0; m < 4; ++m) dst##8[m] = PG8_CAT8(*(const LAS bf16x8*)(lds + PG8_SA(b, h) + aoff + m * 2048), *(const LAS bf16x8*)(lds + PG8_SA(b, h) + aoff + m * 2048 + 1024)); } \
        else { _Pragma("unroll") for (int m = 0; m < 4; ++m) _Pragma("unroll") for (int k = 0; k < 2; ++k) dst[m][k] = *(const LAS bf16x8*)(lds + PG8_SA(b, h) + aoff + m * 2048 + k * 1024); } } while (0)
#define PG8_LDB(dst, b, h) do { if (Epi::FP8) { _Pragma("unroll") for (int n = 0; n < 2; ++n) dst##8[n] = PG8_CAT8(*(const LAS bf16x8*)(lds + PG8_SB(b, h) + boff + n * 2048), *(const LAS bf16x8*)(lds + PG8_SB(b, h) + boff + n * 2048 + 1024)); } \
        else { _Pragma("unroll") for (int n = 0; n < 2; ++n) _Pragma("unroll") for (int k = 0; k < 2; ++k) dst[n][k] = *(const LAS bf16x8*)(lds + PG8_SB(b, h) + boff + n * 2048 + k * 1024); } } while (0)
#define PG8_MMA(ai, bj, At, Bt) do { __builtin_amdgcn_s_setprio(1); \
        if (Epi::FP8) { _Pragma("unroll") for (int m = 0; m < 4; ++m) _Pragma("unroll") for (int n = 0; n < 2; ++n) \
                acc[ai][bj][m][n] = __builtin_amdgcn_mfma_scale_f32_16x16x128_f8f6f4(Bt##8[n], At##8[m], acc[ai][bj][m][n], 0, 0, 0, 0x7f7f7f7f, 0, 0x7f7f7f7f); \
              \
            _Pragma("unroll") for (int m = 0; m < 4; ++m) _Pragma("unroll") for (int n = 0; n < 2; ++n) asm volatile("" : "+v"(acc[ai][bj][m][n])); \
        } else { _Pragma("unroll") for (int m = 0; m < 4; ++m) _Pragma("unroll") for (int n = 0; n < 2; ++n) _Pragma("unroll") for (int k = 0; k < 2; ++k) \
            acc[ai][bj][m][n] = __builtin_amdgcn_mfma_f32_16x16x32_bf16(Bt[n][k], At[m][k], acc[ai][bj][m][n], 0, 0, 0); } \
        __builtin_amdgcn_s_setprio(0); } while (0)
#define PG8_WAIT_V(n) asm volatile("s_waitcnt vmcnt(" #n ")" ::: "memory")
#define PG8_WAIT_VN(a) asm volatile("s_waitcnt vmcnt(%0)" :: "n"(a) : "memory")
#define PG8_WAIT_L(n) asm volatile("s_waitcnt lgkmcnt(" #n ")" ::: "memory")
#define PG8_BAR __builtin_amdgcn_s_barrier()
#define PG8_SCHED __builtin_amdgcn_sched_barrier(0)
    Unit cur, nxt; int ui = 0;
    if (!S.next(0, cur)) return;
    f32x4 acc[2][2][4][2];
#pragma unroll
    for (int a = 0; a < 2; ++a)
#pragma unroll
        for (int b = 0; b < 2; ++b)
#pragma unroll
            for (int m = 0; m < 4; ++m)
#pragma unroll
                for (int n = 0; n < 2; ++n) acc[a][b][m][n] = (f32x4){0.f, 0.f, 0.f, 0.f};
    bf16x8 At[4][2], B0[2][2], B1[2][2]; i32x8v At8[4], B08[2], B18[2];
    unsigned offC[2][2];
    S.a_offsets(cur, 0, offC);
    const char* cB = S.b_tile(cur);
    PG8_STAGE(PG8_SB(0, 0), cB, voffB); PG8_STAGE(PG8_SB(0, 1), cB + hstep, voffB); PG8_STAGEA(PG8_SA(0, 0), 0, offC[0]); PG8_STAGEA1(PG8_SA(0, 1), 0);
    if (wr == 1) PG8_BAR;
    PG8_WAIT_V(2); PG8_BAR;
    PG8_STAGE(PG8_SB(1, 0), cB + kstep, voffB); PG8_STAGEA(PG8_SA(1, 0), kstep, offC[0]); PG8_STAGE(PG8_SB(1, 1), cB + hstep + kstep, voffB);
    PG8_WAIT_V(0); PG8_BAR;
    for (;;) {
        const bool has_next = S.next(ui + 1, nxt);
        const char* nB = has_next ? S.b_tile(nxt) : cB;
#define PG8_PAIR(t_, last_, WA, WC) do { const int t = (t_); const bool last = (last_); \
            const size_t k1 = (size_t)(t + 1) * kstep; \
            const size_t k2 = last ? 0 : (size_t)(t + 2) * kstep, k3 = k2 + kstep; \
            const char* b2 = last ? nB : cB + (size_t)(t + 2) * kstep; const char* b3 = b2 + kstep; \
              \
            PG8_LDB(B0, 0, 0); PG8_LDB(B1, 0, 1); PG8_SCHED; PG8_LDA(At, 0, 0); PG8_STAGEA1(PG8_SA(1, 1), k1); \
            PG8_WAIT_VN(WA); PG8_WAIT_L(0); PG8_BAR; PG8_MMA(0, 0, At, B0); PG8_MMA(0, 1, At, B1); PG8_BAR; PG8_SCHED; \
            if (last && has_next) S.a_offsets(nxt, ui + 1, offC);        \
              \
            PG8_LDA(At, 0, 1); PG8_STAGE(PG8_SB(0, 0), b2, voffB); PG8_STAGE(PG8_SB(0, 1), b2 + hstep, voffB); PG8_STAGEA(PG8_SA(0, 0), k2, offC[0]); \
            PG8_WAIT_VN(WA); PG8_WAIT_L(0); PG8_BAR; PG8_MMA(1, 0, At, B0); PG8_MMA(1, 1, At, B1); PG8_BAR; PG8_SCHED; \
              \
            PG8_LDB(B0, 1, 0); PG8_LDB(B1, 1, 1); PG8_SCHED; PG8_LDA(At, 1, 0); PG8_STAGEA1(PG8_SA(0, 1), k2); \
            PG8_WAIT_VN(WC); PG8_WAIT_L(0); PG8_BAR; PG8_MMA(0, 0, At, B0); PG8_MMA(0, 1, At, B1); PG8_BAR; PG8_SCHED; \
              \
            PG8_LDA(At, 1, 1); PG8_STAGE(PG8_SB(1, 0), b3, voffB); PG8_STAGE(PG8_SB(1, 1), b3 + hstep, voffB); PG8_STAGEA(PG8_SA(1, 0), k3, offC[0]); \
            PG8_WAIT_VN(WC); PG8_WAIT_L(0); PG8_BAR; PG8_MMA(1, 0, At, B0); PG8_MMA(1, 1, At, B1); PG8_BAR; PG8_SCHED; } while (0)
        if (Epi::PEEL) { PG8_PAIR(0, false, 8 + Epi::NVM, 8);
            for (int tt = 2; tt < nt; tt += 2) PG8_PAIR(tt, tt == nt - 2, 8, 8); }
        else { for (int tt = 0; tt < nt; tt += 2) PG8_PAIR(tt, tt == nt - 2, 8, 8); }
#undef PG8_PAIR
        if (ALIGN || !has_next) { if (wr == 0) PG8_BAR; }
        MFMA_DRAIN();
        { const int l2 = opaque_tid() & 63; E(acc, cur, wr, wc, l2 & 15, l2 >> 4); }
        PG8_SCHED;
        if (!has_next) break;
#pragma unroll
        for (int a = 0; a < 2; ++a)
#pragma unroll
            for (int b = 0; b < 2; ++b)
#pragma unroll
                for (int m = 0; m < 4; ++m)
#pragma unroll
                    for (int n = 0; n < 2; ++n) acc[a][b][m][n] = (f32x4){0.f, 0.f, 0.f, 0.f};
        cur = nxt; cB = nB; ++ui;
        if (ALIGN) { if (wr == 1) PG8_BAR; }
    }
    PG8_WAIT_V(0);
    PG8_BAR;
#undef PG8_SA
#undef PG8_SB
#undef PG8_STAGE
#undef PG8_STAGEA
#undef PG8_LDA
#undef PG8_LDB
#undef PG8_MMA
#undef PG8_WAIT_V
#undef PG8_WAIT_L
#undef PG8_BAR
#undef PG8_SCHED
}
}

struct Args { const float* in[15]; float* out; unsigned char* ws; int ph_lo, ph_hi, li, pad; };
struct Ctx {
    LAS unsigned char* lds; int tid, lane, wave, G, wg;
    const float *x, *w_in, *b_in, *conv_w, *mh_g, *w_out, *ln_mix_g, *ln_mix_b, *router_w, *router_b, *w_gate, *w_up, *w_down, *ln_moe_g, *ln_moe_b;
    float* out; unsigned char* ws;
};

__device__ __forceinline__ void load_row_bf16(const bf16_t* row, int lane, float (&v)[16]) {
    const u32x4 a = *(const u32x4*)(row + 8 * lane), b = *(const u32x4*)(row + 512 + 8 * lane);
    float t[8]; unpack8(a, t);
#pragma unroll
    for (int i = 0; i < 8; ++i) v[i] = t[i];
    unpack8(b, t);
#pragma unroll
    for (int i = 0; i < 8; ++i) v[8 + i] = t[i];
}
__device__ __forceinline__ void load_row_f32(const float* row, int lane, float (&v)[16]) {
#pragma unroll
    for (int j = 0; j < 2; ++j)
#pragma unroll
        for (int q = 0; q < 2; ++q) { const f32x4 a = *(const f32x4*)(row + 512 * j + 8 * lane + 4 * q);
            v[8 * j + 4 * q + 0] = a[0]; v[8 * j + 4 * q + 1] = a[1]; v[8 * j + 4 * q + 2] = a[2]; v[8 * j + 4 * q + 3] = a[3]; }
}
__device__ __forceinline__ void store_row_bf16(bf16_t* row, int lane, const float (&v)[16]) {
    u32x4 a, b; a.x = pk2(v[0], v[1]); a.y = pk2(v[2], v[3]); a.z = pk2(v[4], v[5]); a.w = pk2(v[6], v[7]);
    b.x = pk2(v[8], v[9]); b.y = pk2(v[10], v[11]); b.z = pk2(v[12], v[13]); b.w = pk2(v[14], v[15]);
    *(u32x4*)(row + 8 * lane) = a; *(u32x4*)(row + 512 + 8 * lane) = b;
}
__device__ __forceinline__ void store_row_f32(float* row, int lane, const float (&v)[16]) {
#pragma unroll
    for (int j = 0; j < 2; ++j)
#pragma unroll
        for (int q = 0; q < 2; ++q) *(f32x4*)(row + 512 * j + 8 * lane + 4 * q) = (f32x4){v[8 * j + 4 * q], v[8 * j + 4 * q + 1], v[8 * j + 4 * q + 2], v[8 * j + 4 * q + 3]};
}
__device__ __forceinline__ void ln_inplace(float (&v)[16], const float (&g)[16], const float (&b)[16], int lane) {
    float s = 0.f;
#pragma unroll
    for (int i = 0; i < 16; ++i) s += v[i];
    const float mean = wave_sum(s, lane) * (1.0f / D); float q = 0.f;
#pragma unroll
    for (int i = 0; i < 16; ++i) { v[i] -= mean; q += v[i] * v[i]; }
    const float rstd = __builtin_amdgcn_rsqf(wave_sum(q, lane) * (1.0f / D) + LN_EPS);
#pragma unroll
    for (int i = 0; i < 16; ++i) v[i] = v[i] * rstd * g[i] + b[i];
}
__device__ __forceinline__ int wperm_idx(int j, int k) { const int h = k >> 9, ln = (k & 511) >> 3, half = (k >> 2) & 1, i = k & 3; return ((j * 2 + h) * 2 + half) * 256 + ln * 4 + i; }
__device__ __forceinline__ void fill_wif(const Ctx& F, int l, LAS float* wif) {
    for (int k = F.tid; k < D; k += NTHR) { const float* src = F.w_in + ((size_t)l * D + k) * PIN + SRC_IF; const f32x4 a = *(const f32x4*)src, b = *(const f32x4*)(src + 4);
        wif[wperm_idx(0, k)] = a[0]; wif[wperm_idx(1, k)] = a[1]; wif[wperm_idx(2, k)] = a[2]; wif[wperm_idx(3, k)] = a[3];
        wif[wperm_idx(4, k)] = b[0]; wif[wperm_idx(5, k)] = b[1]; wif[wperm_idx(6, k)] = b[2]; wif[wperm_idx(7, k)] = b[3]; }
}
template <int NR, int NJ> __device__ __forceinline__ void row_dots(const float (&v)[NR][16], LAS const float* tab, int lane, float (&out)[NR * NJ]) {
#pragma unroll
    for (int j = 0; j < NJ; ++j) {
        float s[NR];
#pragma unroll
        for (int rr = 0; rr < NR; ++rr) s[rr] = 0.f;
#pragma unroll
        for (int hh = 0; hh < 4; ++hh) { const f32x4 w = *(LAS const f32x4*)(tab + (j * 4 + hh) * 256 + lane * 4);
#pragma unroll
            for (int rr = 0; rr < NR; ++rr) s[rr] += v[rr][4 * hh] * w[0] + v[rr][4 * hh + 1] * w[1] + v[rr][4 * hh + 2] * w[2] + v[rr][4 * hh + 3] * w[3]; }
#pragma unroll
        for (int rr = 0; rr < NR; ++rr) out[rr * NJ + j] = s[rr]; }
}
__device__ __forceinline__ int idx16(int lane) { return ((lane >> 5) & 1) * 8 + ((lane >> 4) & 1) * 4 + ((lane >> 3) & 1) * 2 + ((lane >> 2) & 1); }
__device__ __forceinline__ float reduce16(const float (&x)[16], int lane) {
    const bool b3 = (lane & 8) != 0, b2 = (lane & 4) != 0;
    float y[8], z[4], u[2];
#pragma unroll
    for (int i = 0; i < 8; ++i) { const auto r = __builtin_amdgcn_permlane32_swap(__float_as_uint(x[i]), __float_as_uint(x[8 + i]), false, false); y[i] = __uint_as_float(r[0]) + __uint_as_float(r[1]); }
#pragma unroll
    for (int i = 0; i < 4; ++i) { const auto r = __builtin_amdgcn_permlane16_swap(__float_as_uint(y[i]), __float_as_uint(y[4 + i]), false, false); z[i] = __uint_as_float(r[0]) + __uint_as_float(r[1]); }
#pragma unroll
    for (int i = 0; i < 2; ++i) { const float keep = b3 ? z[2 + i] : z[i], send = b3 ? z[i] : z[2 + i]; u[i] = keep + dpp_mov<0x128>(send); }
    const float keep = b2 ? u[1] : u[0], send = b2 ? u[0] : u[1]; float t = keep + dpp_mov<0x141>(send);
    t += dpp_mov<0x4E>(t); t += dpp_mov<0xB1>(t);
    return t;
}
__device__ __forceinline__ void ln_inplace_lds(float (&v)[16], LAS const float* gb, int lane) {
    float s = 0.f;
#pragma unroll
    for (int i = 0; i < 16; ++i) s += v[i];
    const float mean = wave_sum(s, lane) * (1.0f / D); float q = 0.f;
#pragma unroll
    for (int i = 0; i < 16; ++i) { v[i] -= mean; q += v[i] * v[i]; }
    const float rstd = __builtin_amdgcn_rsqf(wave_sum(q, lane) * (1.0f / D) + LN_EPS);
#pragma unroll
    for (int hh = 0; hh < 4; ++hh) { const f32x4 g4 = *(LAS const f32x4*)(gb + hh * 256 + lane * 4), b4 = *(LAS const f32x4*)(gb + (4 + hh) * 256 + lane * 4);
#pragma unroll
        for (int i = 0; i < 4; ++i) v[4 * hh + i] = v[4 * hh + i] * rstd * g4[i] + b4[i]; }
}
__device__ __forceinline__ void unpack_row(const u32x4 a, const u32x4 b, float (&v)[16]) {
    float t[8]; unpack8(a, t);
#pragma unroll
    for (int i = 0; i < 8; ++i) v[i] = t[i];
    unpack8(b, t);
#pragma unroll
    for (int i = 0; i < 8; ++i) v[8 + i] = t[i];
}

__device__ __forceinline__ void transpose_item(const float* src, int lds_, bf16_t* dst, int ldd, LAS float* scr, int lane) {
#pragma unroll 8
    for (int i = 0; i < 32; ++i) { const int kk = 2 * i + (lane >> 5); scr[kk * 33 + (lane & 31)] = src[(size_t)kk * lds_ + (lane & 31)]; }
    LDS_WAIT(); asm volatile("" ::: "memory");
    const int c = lane & 7;
#pragma unroll
    for (int j = 0; j < 4; ++j) { const int n = (lane >> 3) + 8 * j; const LAS float* s = scr + (8 * c) * 33 + n;
        u32x4 o; o.x = pk2(s[0 * 33], s[1 * 33]); o.y = pk2(s[2 * 33], s[3 * 33]); o.z = pk2(s[4 * 33], s[5 * 33]); o.w = pk2(s[6 * 33], s[7 * 33]);
        *(u32x4*)(dst + (size_t)n * ldd + 8 * c) = o; }
    LDS_WAIT(); asm volatile("" ::: "memory");
}
__device__ __forceinline__ void transpose_item_fp8(const float* src, int lds_, unsigned char* dst8, int ldd8, float scale, LAS float* scr, int lane) {
#pragma unroll 8
    for (int i = 0; i < 32; ++i) { const int kk = 2 * i + (lane >> 5); scr[kk * 33 + (lane & 31)] = src[(size_t)kk * lds_ + (lane & 31)]; }
    LDS_WAIT(); asm volatile("" ::: "memory");
    const int c = lane & 7;
#pragma unroll
    for (int j = 0; j < 4; ++j) { const int n = (lane >> 3) + 8 * j; const LAS float* s = scr + (8 * c) * 33 + n;
        u32x2 o; o.x = pack4_fp8c((f32x4){s[0 * 33], s[1 * 33], s[2 * 33], s[3 * 33]}, scale); o.y = pack4_fp8c((f32x4){s[4 * 33], s[5 * 33], s[6 * 33], s[7 * 33]}, scale);
        *(u32x2*)(dst8 + (size_t)n * ldd8 + 8 * c) = o; }
    LDS_WAIT(); asm volatile("" ::: "memory");
}
__device__ __forceinline__ void p0_prologue(const Ctx& F) {
    LAS float* scr = (LAS float*)(F.lds + 32768 + F.wave * 8704);
    const int gw = F.wg * NWAVES + F.wave, NGW = F.G * NWAVES;
    constexpr int I_IN = 16 * 112, I_OUT = 16 * 32, I_GU = 16 * 16 * 32, I_DN = 16 * 8 * 32, I_L = I_IN + I_OUT + I_GU + I_DN;
    bf16_t* WIN = (bf16_t*)(F.ws + WS_WIN); bf16_t* WOUT = (bf16_t*)(F.ws + WS_WOUT); bf16_t* WGU = (bf16_t*)(F.ws + WS_WGU); bf16_t* WDN = (bf16_t*)(F.ws + WS_WDN);
    for (int it = gw; it < DEPTH * I_L; it += NGW) {
        const int l = it / I_L; int r = it % I_L;
        if (r < I_IN) { const int kb = r / 112, nb = r % 112, n0 = 32 * nb, grp = n0 >> 9;
            const int src0 = win_src_col(n0); (void)grp;
            transpose_item_fp8(F.w_in + ((size_t)l * D + 64 * kb) * PIN + src0, PIN, (unsigned char*)WIN + ((size_t)l * NP + n0) * D + 64 * kb, D, WIN_SCALE, scr, F.lane); continue; }
        r -= I_IN;
        if (r < I_OUT) { const int kb = r / 32, nb = r % 32;
            transpose_item_fp8(F.w_out + ((size_t)l * D + 64 * kb) * D + 32 * nb, D, (unsigned char*)WOUT + ((size_t)l * D + 32 * nb) * D + 64 * kb, D, WOUT_SCALE, scr, F.lane); continue; }
        r -= I_OUT;
        if (r < I_GU) { const int e = r / 512, q = r % 512, kb = q / 32, nb = q % 32, n0 = 32 * nb;
            const int pn = n0 >> 8, w = n0 & 255; const float* srcm = ((w >> 5) & 1) ? F.w_up : F.w_gate; const int scol = pn * 128 + 32 * (w >> 6);
            transpose_item_fp8(srcm + (((size_t)l * NE + e) * D + 64 * kb) * DFF + scol, DFF, (unsigned char*)WGU + (((size_t)l * NE + e) * 1024 + n0) * D + 64 * kb, D, WGU_SCALE, scr, F.lane); continue; }
        r -= I_GU;
        { const int e = r / 256, q = r % 256, kb = q / 32, nb = q % 32;
            transpose_item_fp8(F.w_down + (((size_t)l * NE + e) * DFF + 64 * kb) * D + 32 * nb, D, (unsigned char*)WDN + (((size_t)l * NE + e) * D + 32 * nb) * DFF + 64 * kb, DFF, WDN_SCALE, scr, F.lane); }
    }
    { u32x4* RFB = (u32x4*)(F.ws + WS_RFB);
      for (int idx = F.wg * NTHR + F.tid; idx < 32 * 64; idx += F.G * NTHR) { const int kk = idx >> 6, ln = idx & 63, rr = ln & 15, qq = ln >> 4; float w[8], wl[8];
#pragma unroll
          for (int i = 0; i < 8; ++i) w[i] = F.router_w[(size_t)(32 * kk + 8 * qq + i) * 16 + rr];
          const u32x4 hi = pack8(w); float hf[8]; unpack8(hi, hf);
#pragma unroll
          for (int i = 0; i < 8; ++i) wl[i] = w[i] - hf[i];
          RFB[(kk * 2) * 64 + ln] = hi; RFB[(kk * 2 + 1) * 64 + ln] = pack8(wl); }
      float* WIFP = (float*)(F.ws + WS_WIFP);
      for (int idx = F.wg * NTHR + F.tid; idx < DEPTH * D; idx += F.G * NTHR) { const int ll = idx >> 10, k = idx & 1023; const float* src = F.w_in + ((size_t)ll * D + k) * PIN + SRC_IF; const f32x4 a = *(const f32x4*)src, b = *(const f32x4*)(src + 4);
          float* dst = WIFP + (size_t)ll * 8 * D;
          dst[wperm_idx(0, k)] = a[0]; dst[wperm_idx(1, k)] = a[1]; dst[wperm_idx(2, k)] = a[2]; dst[wperm_idx(3, k)] = a[3]; dst[wperm_idx(4, k)] = b[0]; dst[wperm_idx(5, k)] = b[1]; dst[wperm_idx(6, k)] = b[2]; dst[wperm_idx(7, k)] = b[3]; } }
    LAS float* wif = (LAS float*)F.lds;
    fill_wif(F, 0, wif);
    __syncthreads();
    bf16_t* X = (bf16_t*)(F.ws + WS_X); float* GATES = (float*)(F.ws + WS_GATES);
    const int npair = M / (2 * NGW);
    f32x4 raw[2][4];
#pragma unroll
    for (int rr = 0; rr < 2; ++rr) { const float* row = F.x + (size_t)(gw + NGW * rr) * D;
#pragma unroll
        for (int jq = 0; jq < 4; ++jq) raw[rr][jq] = *(const f32x4*)(row + 512 * (jq >> 1) + 8 * F.lane + 4 * (jq & 1)); }
    for (int it = 0; it < npair; ++it) {
        float v[2][16];
#pragma unroll
        for (int rr = 0; rr < 2; ++rr)
#pragma unroll
            for (int jq = 0; jq < 4; ++jq) { v[rr][4 * jq] = raw[rr][jq][0]; v[rr][4 * jq + 1] = raw[rr][jq][1]; v[rr][4 * jq + 2] = raw[rr][jq][2]; v[rr][4 * jq + 3] = raw[rr][jq][3]; }
        if (it + 1 < npair) {
#pragma unroll
            for (int rr = 0; rr < 2; ++rr) { const float* row = F.x + (size_t)(gw + NGW * (2 * it + 2 + rr)) * D;
#pragma unroll
                for (int jq = 0; jq < 4; ++jq) raw[rr][jq] = *(const f32x4*)(row + 512 * (jq >> 1) + 8 * F.lane + 4 * (jq & 1)); } }
        float part[16]; row_dots<2, 8>(v, wif, F.lane, part);
        const float tot = reduce16(part, F.lane);
#pragma unroll
        for (int rr = 0; rr < 2; ++rr) store_row_bf16(X + (size_t)(gw + NGW * (2 * it + rr)) * D, F.lane, v[rr]);
#pragma unroll
        for (int rr = 0; rr < 2; ++rr)
#pragma unroll
            for (int j = 0; j < 2; ++j) { u32x2 f8; f8.x = pack4_fp8c((f32x4){v[rr][8 * j], v[rr][8 * j + 1], v[rr][8 * j + 2], v[rr][8 * j + 3]}, 1.0f); f8.y = pack4_fp8c((f32x4){v[rr][8 * j + 4], v[rr][8 * j + 5], v[rr][8 * j + 6], v[rr][8 * j + 7]}, 1.0f);
                *(u32x2*)(F.ws + WS_XF + (size_t)(gw + NGW * (2 * it + rr)) * D + 512 * j + 8 * F.lane) = f8; }
        if ((F.lane & 3) == 0) { const int ix = idx16(F.lane), rr = ix >> 3, j = ix & 7; GATES[(size_t)(gw + NGW * (2 * it + rr)) * 8 + j] = tot + F.b_in[SRC_IF + j]; }
    }
}

typedef short s16x4 __attribute__((ext_vector_type(4)));
__device__ __forceinline__ void tr_issue(s16x4& d, unsigned addr) { asm volatile("ds_read_b64_tr_b16 %0, %1" : "=&v"(d) : "v"(addr) : "memory"); }
#define TR_ISSUE_OFF(d, addr, off) asm volatile("ds_read_b64_tr_b16 %0, %1 offset:%2" : "=&v"(d) : "v"(addr), "i"(off) : "memory")
#define TR_WAIT4(a, b, c, d) asm volatile("s_waitcnt lgkmcnt(0)" : "+v"(a), "+v"(b), "+v"(c), "+v"(d) :: "memory")
#define TR_WAIT2(a, b) asm volatile("s_waitcnt lgkmcnt(0)" : "+v"(a), "+v"(b) :: "memory")
#define TR_WAIT8(a, b, c, d, e, f, g, h) asm volatile("s_waitcnt lgkmcnt(0)" : "+v"(a), "+v"(b), "+v"(c), "+v"(d), "+v"(e), "+v"(f), "+v"(g), "+v"(h) :: "memory")
__device__ __forceinline__ bf16x8 cat8(s16x4 lo, s16x4 hi) { return __builtin_shufflevector(lo, hi, 0, 1, 2, 3, 4, 5, 6, 7); }

__device__ __forceinline__ float wave_incl_scan_add(float x, int lane) {
#pragma unroll
    for (int o = 1; o < 64; o <<= 1) { const float t = shup(x, o, lane); if (lane >= o) x += t; }
    return x;
}
__device__ __forceinline__ float wave_incl_scan_max(float x, int lane) {
#pragma unroll
    for (int o = 1; o < 64; o <<= 1) { const float t = shup(x, o, lane); if (lane >= o) x = fmaxf(x, t); }
    return x;
}
__device__ __forceinline__ float log_sigmoid(float f) { return fminf(f, 0.f) - log1pf(expf(-fabsf(f))); }
__device__ __forceinline__ int off_tr2(int row, int ch) { return row * 256 + ((ch ^ (2 * ((row & 3) | ((row >> 1) & 4)))) << 4); }

__device__ __forceinline__ void p2_local_conv(const Ctx& F, int l) {
    const float* GATES = (const float*)(F.ws + WS_GATES);
    unsigned char* CS = F.ws + WS_CS; float* AA = (float*)(F.ws + WS_AA); float* BB = (float*)(F.ws + WS_BB); float* NL = (float*)(F.ws + WS_NL);
    float* ML = (float*)(F.ws + WS_ML); float* GC = (float*)(F.ws + WS_GC);
    LAS float* se = (LAS float*)(F.lds + 65536);
    const int w = F.wave, r = F.lane & 15, q = F.lane >> 4;
    const int rowl = 8 * q + (r >> 2);
    unsigned a2[8];
#pragma unroll
    for (int ct = 0; ct < 8; ++ct) a2[ct] = (unsigned)(off_tr2(rowl, 2 * ct + ((r & 3) >> 1)) + 8 * (r & 1));
    const unsigned a2k = (unsigned)(off_tr2(rowl, 2 * w + ((r & 3) >> 1)) + 8 * (r & 1));
    const int NU = NB * NH * NCH;
    u32x4 kreg[2], vreg[2]; const unsigned char* CVp = F.ws + WS_CV;
    int u = F.wg;
    if (u < NU) { const int c = u % NCH, h = (u / NCH) % NH, b = u / (NCH * NH), t0 = b * SEQ + c * CHK;
#pragma unroll
        for (int i = 0; i < 2; ++i) { const int cq = F.tid + NTHR * i, row = cq >> 3, cp = cq & 7; const unsigned char* src = CVp + (size_t)(t0 + row) * NCV + h * DH + cp * 16;
            kreg[i] = *(const u32x4*)(src + CK); vreg[i] = *(const u32x4*)(src + CVV); } }
    float* PM = (float*)(F.ws + WS_PM);
    for (int k = w; F.wg + k * F.G < NU && k < 16; k += NWAVES) {
        const int uu = F.wg + k * F.G, c = uu % NCH, h = (uu / NCH) % NH, b = uu / (NCH * NH), bh = b * NH + h, t0 = b * SEQ + c * CHK, ln = F.lane;
        const float f0 = GATES[(size_t)(t0 + ln) * 8 + 4 + h], i0 = GATES[(size_t)(t0 + ln) * 8 + h], f1 = GATES[(size_t)(t0 + 64 + ln) * 8 + 4 + h], i1 = GATES[(size_t)(t0 + 64 + ln) * 8 + h];
        const float a0 = wave_incl_scan_add(log_sigmoid(f0), ln); const float tot0 = rdlane(a0, 63);
        const float a1 = wave_incl_scan_add(log_sigmoid(f1), ln) + tot0; const float g = rdlane(a1, 63);
        const float b0 = i0 - a0, b1 = i1 - a1;
        const float m0 = wave_incl_scan_max(b0, ln); const float t0m = rdlane(m0, 63); const float m1 = fmaxf(wave_incl_scan_max(b1, ln), t0m); const float maxb = rdlane(m1, 63);
        const float sc = 0.08838834764831845f;
        se[k * 128 + ln] = expf(b0 - maxb) * sc; se[k * 128 + 64 + ln] = expf(b1 - maxb) * sc;
        const size_t o = (size_t)bh * SEQ + c * CHK + ln; AA[o] = a0; AA[o + 64] = a1; BB[o] = b0; BB[o + 64] = b1; PM[o] = m0; PM[o + 64] = m1;
        if (ln == 0) { ML[bh * NCH + c] = g + maxb; GC[bh * NCH + c] = g; }
    }
    bf16_t* Y = (bf16_t*)F.out; const unsigned char* CV = F.ws + WS_CV;
#define CV_LOAD8(dst, p_) do { const u32x2 w_ = *(const u32x2*)(p_); const f32x4 lo_ = unpack4_fp8(w_.x), hi_ = unpack4_fp8(w_.y); dst[0] = lo_[0]; dst[1] = lo_[1]; dst[2] = lo_[2]; dst[3] = lo_[3]; dst[4] = hi_[0]; dst[5] = hi_[1]; dst[6] = hi_[2]; dst[7] = hi_[3]; } while (0)
    const int ch0 = 8 * F.lane, ts = (F.wg * NWAVES + F.wave) * 32;
    float um1[8], um2[8];
    LAS float* cwl = (LAS float*)(F.lds + 65536 + 8192);
    for (int i = F.tid; i < 3 * 512; i += NTHR) cwl[i] = F.conv_w[(size_t)l * 3 * 512 + i];
#define CW_LOAD() float w0[8], w1[8], w2[8]; do { _Pragma("unroll") for (int qq = 0; qq < 2; ++qq) { const f32x4 a = *(LAS const f32x4*)(cwl + ch0 + 4 * qq), b = *(LAS const f32x4*)(cwl + 512 + ch0 + 4 * qq), c = *(LAS const f32x4*)(cwl + 1024 + ch0 + 4 * qq); \
          _Pragma("unroll") for (int j = 0; j < 4; ++j) { w0[4 * qq + j] = a[j]; w1[4 * qq + j] = b[j]; w2[4 * qq + j] = c[j]; } } } while (0)
    if ((ts % SEQ) == 0) {
#pragma unroll
        for (int i = 0; i < 8; ++i) { um1[i] = 0.f; um2[i] = 0.f; }
    } else { float a[8], b[8];
        CV_LOAD8(a, CV + (size_t)(ts - 1) * NCV + CU + ch0); CV_LOAD8(b, CV + (size_t)(ts - 2) * NCV + CU + ch0);
#pragma unroll
        for (int i = 0; i < 8; ++i) { um1[i] = a[i]; um2[i] = b[i]; } }
    __syncthreads();
    int kidx = 0;
    for (; u < NU; u += F.G, ++kidx) {
        const int c = u % NCH, h = (u / NCH) % NH, b = u / (NCH * NH), bh = b * NH + h, t0 = b * SEQ + c * CHK;
#pragma unroll
        for (int i = 0; i < 2; ++i) { const int cq = F.tid + NTHR * i, row = cq >> 3, cp = cq & 7;
            *(LAS u32x4*)(F.lds + off_tr2(row, 2 * cp)) = fp8x8_to_bf16x8((u32x2){kreg[i].x, kreg[i].y}); *(LAS u32x4*)(F.lds + off_tr2(row, 2 * cp + 1)) = fp8x8_to_bf16x8((u32x2){kreg[i].z, kreg[i].w});
            *(LAS u32x4*)(F.lds + 32768 + off_tr2(row, 2 * cp)) = fp8x8_to_bf16x8((u32x2){vreg[i].x, vreg[i].y}); *(LAS u32x4*)(F.lds + 32768 + off_tr2(row, 2 * cp + 1)) = fp8x8_to_bf16x8((u32x2){vreg[i].z, vreg[i].w}); }
        u32x2 cvr[4][3]; const bool cv_on = kidx < 8;
        if (cv_on) {
#pragma unroll
            for (int tt = 0; tt < 4; ++tt) { const unsigned char* pr = CV + (size_t)(ts + 4 * kidx + tt) * NCV + ch0; cvr[tt][0] = *(const u32x2*)(pr + CU); cvr[tt][2] = *(const u32x2*)(pr + CGB); } }
        { const int un = u + F.G;
          if (un < NU) { const int c2 = un % NCH, h2 = (un / NCH) % NH, b2 = un / (NCH * NH), t2 = b2 * SEQ + c2 * CHK;
#pragma unroll
            for (int i = 0; i < 2; ++i) { const int cq = F.tid + NTHR * i, row = cq >> 3, cp = cq & 7; const unsigned char* src = CVp + (size_t)(t2 + row) * NCV + h2 * DH + cp * 16;
                kreg[i] = *(const u32x4*)(src + CK); vreg[i] = *(const u32x4*)(src + CVV); }
 } }
        __syncthreads();
        f32x4 acc[8], nacc = (f32x4){0.f, 0.f, 0.f, 0.f};
#pragma unroll
        for (int vt = 0; vt < 8; ++vt) acc[vt] = (f32x4){0.f, 0.f, 0.f, 0.f};
        const bf16x8 ones = (bf16x8){(short)0x3F80, (short)0x3F80, (short)0x3F80, (short)0x3F80, (short)0x3F80, (short)0x3F80, (short)0x3F80, (short)0x3F80};
#pragma unroll
        for (int kk = 0; kk < 4; ++kk) {
            s16x4 k0, k1, vv[16]; TR_ISSUE_OFF(k0, a2k, kk * 8192); TR_ISSUE_OFF(k1, a2k, kk * 8192 + 1024);
#pragma unroll
            for (int vp = 0; vp < 4; ++vp) { TR_ISSUE_OFF(vv[4 * vp], a2[2 * vp], 32768 + kk * 8192); TR_ISSUE_OFF(vv[4 * vp + 1], a2[2 * vp], 32768 + kk * 8192 + 1024);
                TR_ISSUE_OFF(vv[4 * vp + 2], a2[2 * vp + 1], 32768 + kk * 8192); TR_ISSUE_OFF(vv[4 * vp + 3], a2[2 * vp + 1], 32768 + kk * 8192 + 1024); }
            const f32x4 e0 = *(LAS const f32x4*)(se + kidx * 128 + 32 * kk + 8 * q), e1 = *(LAS const f32x4*)(se + kidx * 128 + 32 * kk + 8 * q + 4);
            TR_WAIT2(k0, k1); TR_WAIT8(vv[0], vv[1], vv[2], vv[3], vv[4], vv[5], vv[6], vv[7]); TR_WAIT8(vv[8], vv[9], vv[10], vv[11], vv[12], vv[13], vv[14], vv[15]);
            float kf[8]; { u32x4 kw; const u32x2 lo = __builtin_bit_cast(u32x2, k0), hi = __builtin_bit_cast(u32x2, k1); kw.x = lo.x; kw.y = lo.y; kw.z = hi.x; kw.w = hi.y; unpack8(kw, kf); }
            kf[0] *= e0[0]; kf[1] *= e0[1]; kf[2] *= e0[2]; kf[3] *= e0[3]; kf[4] *= e1[0]; kf[5] *= e1[1]; kf[6] *= e1[2]; kf[7] *= e1[3];
            const bf16x8 kfs = __builtin_bit_cast(bf16x8, pack8(kf));
            nacc = __builtin_amdgcn_mfma_f32_16x16x32_bf16(ones, kfs, nacc, 0, 0, 0);
#pragma unroll
            for (int vp = 0; vp < 4; ++vp) {
                acc[2 * vp] = __builtin_amdgcn_mfma_f32_16x16x32_bf16(cat8(vv[4 * vp], vv[4 * vp + 1]), kfs, acc[2 * vp], 0, 0, 0);
                acc[2 * vp + 1] = __builtin_amdgcn_mfma_f32_16x16x32_bf16(cat8(vv[4 * vp + 2], vv[4 * vp + 3]), kfs, acc[2 * vp + 1], 0, 0, 0); }
        }
        MFMA_DRAIN();
        unsigned char* Cout = CS + ((size_t)bh * NCH + c) * (DH * DH) + (size_t)(16 * w + r) * DH + 16 * q;
#pragma unroll
        for (int g4 = 0; g4 < 2; ++g4) { unsigned x[4];
#pragma unroll
            for (int v = 0; v < 4; ++v) x[v] = pack4_fp8c(acc[4 * g4 + v], CL_SCALE);
            lane_row_transpose4(x);
            *(u32x4*)(Cout + 64 * g4) = (u32x4){x[0], x[1], x[2], x[3]}; }
        if (q == 0) NL[((size_t)bh * NCH + c) * DH + 16 * w + r] = nacc[0];
        if (cv_on) { CW_LOAD();
#pragma unroll
            for (int tt = 0; tt < 4; ++tt) { float y[8];
#pragma unroll
                for (int hf = 0; hf < 2; ++hf) {
                    const f32x4 uu4 = unpack4_fp8(hf ? cvr[tt][0].y : cvr[tt][0].x), gb4 = unpack4_fp8(hf ? cvr[tt][2].y : cvr[tt][2].x);
                    const f32x4 w04 = (f32x4){w0[4 * hf], w0[4 * hf + 1], w0[4 * hf + 2], w0[4 * hf + 3]}, w14 = (f32x4){w1[4 * hf], w1[4 * hf + 1], w1[4 * hf + 2], w1[4 * hf + 3]}, w24 = (f32x4){w2[4 * hf], w2[4 * hf + 1], w2[4 * hf + 2], w2[4 * hf + 3]};
                    const f32x4 u14 = (f32x4){um1[4 * hf], um1[4 * hf + 1], um1[4 * hf + 2], um1[4 * hf + 3]}, u24 = (f32x4){um2[4 * hf], um2[4 * hf + 1], um2[4 * hf + 2], um2[4 * hf + 3]};
                    const f32x4 y4 = gb4 * (w24 * uu4 + w14 * u14 + w04 * u24);
#pragma unroll
                    for (int i = 0; i < 4; ++i) { y[4 * hf + i] = y4[i]; um2[4 * hf + i] = um1[4 * hf + i]; um1[4 * hf + i] = uu4[i]; } }
                { u32x2 yw; yw.x = pack4_fp8c((f32x4){y[0], y[1], y[2], y[3]}, Y_SCALE); yw.y = pack4_fp8c((f32x4){y[4], y[5], y[6], y[7]}, Y_SCALE); *(u32x2*)((unsigned char*)Y + (size_t)(ts + 4 * kidx + tt) * D + 512 + ch0) = yw; } } }
        __syncthreads();
    }
    if (kidx > 8) kidx = 8;
    for (int tcur = ts + 4 * kidx; tcur < ts + 32; ++tcur) { CW_LOAD(); float gc[8], xc[8], gb[8], y[8]; const unsigned char* pr = CV + (size_t)tcur * NCV + ch0;
        CV_LOAD8(gc, pr + CU); CV_LOAD8(gb, pr + CGB); (void)xc;
#pragma unroll
        for (int i = 0; i < 8; ++i) { const float uu = gc[i]; y[i] = gb[i] * (w2[i] * uu + w1[i] * um1[i] + w0[i] * um2[i]); um2[i] = um1[i]; um1[i] = uu; }
        { u32x2 yw; yw.x = pack4_fp8c((f32x4){y[0], y[1], y[2], y[3]}, Y_SCALE); yw.y = pack4_fp8c((f32x4){y[4], y[5], y[6], y[7]}, Y_SCALE); *(u32x2*)((unsigned char*)Y + (size_t)tcur * D + 512 + ch0) = yw; } }
#undef CV_LOAD8
#undef CW_LOAD
}

__device__ __forceinline__ void p3_scan(const Ctx& F) {
    const unsigned char* CS = F.ws + WS_CS; const float* NL = (const float*)(F.ws + WS_NL); float* NST = (float*)(F.ws + WS_NST); const float* ML = (const float*)(F.ws + WS_ML); const float* GC = (const float*)(F.ws + WS_GC); float* MST = (float*)(F.ws + WS_MST);
    unsigned char* CSB = (unsigned char*)F.out + CSB_OFF;
    static_assert(NCH == 64, "lane c of wave 0 keeps chunk c");
    LAS float* ssp = (LAS float*)F.lds; LAS float* ssl = ssp + NCH;
    for (int it0 = F.wg * NTHR; it0 < 32 * 4096; it0 += F.G * NTHR) {
        const int bh = __builtin_amdgcn_readfirstlane(it0 >> 12), e4 = (it0 & 4095) + F.tid;
        const unsigned* cp = (const unsigned*)(CS + (size_t)bh * NCH * (DH * DH)) + e4; unsigned* op = (unsigned*)(CSB + (size_t)bh * NCH * (DH * DH)) + e4;
        const bool do_n = e4 < DH;
        unsigned cw[NCH]; float vn[NCH];
#pragma unroll
        for (int c = 0; c < NCH; ++c) cw[c] = cp[(size_t)c * 4096];
#pragma unroll
        for (int c = 0; c < NCH; ++c) vn[c] = 0.f;
        if (do_n) {
#pragma unroll
            for (int c = 0; c < NCH; ++c) vn[c] = NL[((size_t)bh * NCH + c) * DH + e4]; }
        __syncthreads();
        if (F.wave == 0) {
            const float mlv = ML[bh * NCH + F.lane], gcv = GC[bh * NCH + F.lane];
            float mprev = 0.f, my_sp = 0.f, my_sl = 0.f, my_m = 0.f;
#pragma unroll
            for (int c = 0; c < NCH; ++c) { const float ml = rdlane(mlv, c), gc = rdlane(gcv, c);
                const float mnew = fmaxf(gc + mprev, ml), sp = __expf(gc + mprev - mnew), sl = __expf(ml - mnew);
                if (F.lane == c) { my_sp = sp; my_sl = sl; my_m = mprev; }
                mprev = mnew; }
            ssp[F.lane] = my_sp; ssl[F.lane] = my_sl; MST[bh * NCH + F.lane] = my_m; }
        __syncthreads();
        f32x4 st = (f32x4){0.f, 0.f, 0.f, 0.f}; float sn = 0.f;
#pragma unroll
        for (int c = 0; c < NCH; ++c) { const float sp = ssp[c], sl = ssl[c];
            op[(size_t)c * 4096] = pack4_fp8c(st, CS_SCALE); if (do_n) NST[((size_t)bh * NCH + c) * DH + e4] = sn;
            const f32x4 v_ = unpack4_fp8(cw[c]) * (1.0f / CL_SCALE);
            st = st * sp + v_ * sl; sn = sn * sp + vn[c] * sl; }
    }
}

__device__ __forceinline__ int off_trv(int row, int ch) { return row * 256 + ((ch ^ (2 * (row & 7))) << 4); }
__device__ __forceinline__ int off_row(int row, int ch) { return row * 256 + ((ch ^ (row & 15)) << 4); }
__device__ __forceinline__ void p4_mlstm_out(const Ctx& F, int l) {
    const unsigned char* WSB = F.ws; const unsigned char* OUTB = (const unsigned char*)F.out;
#define P4_WS16(off_) (*(const u32x4*)(WSB + (unsigned)(off_)))
#define P4_WSF(off_) (*(const float*)(WSB + (unsigned)(off_)))
#define P4_WS8(off_) (*(const u32x2*)(WSB + (unsigned)(off_)))
#define P4_OUT16(off_) (*(const u32x4*)(OUTB + (unsigned)(off_)))
    const unsigned char* CSB = (const unsigned char*)F.out + CSB_OFF;
    const float* AA = (const float*)(F.ws + WS_AA); const float* BB = (const float*)(F.ws + WS_BB); const float* PM = (const float*)(F.ws + WS_PM);
    const float* NL = (const float*)(F.ws + WS_NST); const float* MST = (const float*)(F.ws + WS_MST); bf16_t* Y = (bf16_t*)F.out;
    LAS float* sa = (LAS float*)(F.lds + 98304); LAS float* sb_ = sa + 128; LAS float* sM = sa + 256; LAS float* sn = sa + 384; LAS float* smg = sa + 512;
    smg[F.tid] = F.mh_g[(size_t)l * 512 + F.tid];
    LAS float* slut = sa + 1024;
    if (F.tid < 256) { const f32x2 cv = __builtin_amdgcn_cvt_pk_f32_fp8(F.tid, false); slut[F.tid] = sigmoidf_(cv[0]); }
    const int w = F.wave < 4 ? F.wave : 11 - F.wave, r = F.lane & 15, q = F.lane >> 4;
    const int rowl = 4 * q + (r >> 2);
    unsigned av[8];
#pragma unroll
    for (int vt = 0; vt < 8; ++vt) av[vt] = (unsigned)(off_trv(rowl, 2 * vt + ((r & 3) >> 1)) + 8 * (r & 1));
    unsigned ak[4];
#pragma unroll
    for (int kk = 0; kk < 4; ++kk) ak[kk] = (unsigned)(65536 + 256 * r + 16 * ((4 * kk + q) ^ r));
    const int NU = NB * NH * NCH;
    u32x4 kreg[2], vreg[2], creg[2]; u32x2 qraw[4];
    const unsigned char* CVp = F.ws + WS_CV; float spre[8] = {0.f, 0.f, 0.f, 0.f, 0.f, 0.f, 0.f, 0.f}; float mst_n = 0.f;
#define P4_SMALL(bh_, c_) do { mst_n = P4_WSF((unsigned)WS_MST + (unsigned)((bh_) * NCH + (c_)) * 4u); if (w == 0) { const unsigned o_ = (unsigned)((bh_) * SEQ + (c_) * CHK + F.lane) * 4u; spre[0] = P4_WSF((unsigned)WS_AA + o_); spre[1] = P4_WSF((unsigned)WS_AA + o_ + 256u); spre[2] = P4_WSF((unsigned)WS_BB + o_); spre[3] = P4_WSF((unsigned)WS_BB + o_ + 256u); \
        const unsigned n_ = (unsigned)(((bh_) * NCH + (c_)) * DH + F.lane) * 4u; spre[4] = P4_WSF((unsigned)WS_NST + n_); spre[5] = P4_WSF((unsigned)WS_NST + n_ + 256u); spre[6] = P4_WSF((unsigned)WS_PM + o_); spre[7] = P4_WSF((unsigned)WS_PM + o_ + 256u); } } while (0)
    int u = F.wg;
    if (u < NU) { const int c = u % NCH, h = (u / NCH) % NH, b = u / (NCH * NH), bh = b * NH + h, t0 = b * SEQ + c * CHK;
        P4_SMALL(bh, c);
#pragma unroll
        for (int i = 0; i < 2; ++i) { const int cq = F.tid + NTHR * i, row = cq >> 3, cp = cq & 7; kreg[i] = P4_WS16((unsigned)WS_CV + (unsigned)((t0 + row) * NCV + CK + h * DH + cp * 16)); }
#pragma unroll
        for (int i = 0; i < 2; ++i) { const int cq = F.tid + NTHR * i, row = cq >> 3, cp = cq & 7;
            vreg[i] = P4_WS16((unsigned)WS_CV + (unsigned)((t0 + row) * NCV + CVV + h * DH + cp * 16));
            creg[i] = P4_OUT16((unsigned)CSB_OFF + (unsigned)((bh * NCH + c) * (DH * DH) + row * DH + cp * 16)); }
#pragma unroll
        for (int kk = 0; kk < 4; ++kk) qraw[kk] = P4_WS8((unsigned)WS_CV + (unsigned)((t0 + 16 * w + r) * NCV + CQ + h * DH + 32 * kk + 8 * q)); }
    for (; u < NU; u += F.G) {
        const int c = u % NCH, h = (u / NCH) % NH, b = u / (NCH * NH), bh = b * NH + h, t0 = b * SEQ + c * CHK;
        const float mst = mst_n;
#pragma unroll
        for (int i = 0; i < 2; ++i) { const int cq = F.tid + NTHR * i, row = cq >> 3, cp = cq & 7;
            *(LAS u32x4*)(F.lds + 65536 + off_row(row, 2 * cp)) = fp8x8_to_bf16x8((u32x2){kreg[i].x, kreg[i].y}); *(LAS u32x4*)(F.lds + 65536 + off_row(row, 2 * cp + 1)) = fp8x8_to_bf16x8((u32x2){kreg[i].z, kreg[i].w}); }
#pragma unroll
        for (int i = 0; i < 2; ++i) { const int cq = F.tid + NTHR * i, row = cq >> 3, cp = cq & 7;
            const int rho = (row & ~31) | ((row & 4) << 2) | ((row >> 1) & 12) | (row & 3);
            *(LAS u32x4*)(F.lds + off_trv(row, 2 * cp)) = fp8x8_to_bf16x8((u32x2){vreg[i].x, vreg[i].y}); *(LAS u32x4*)(F.lds + off_trv(row, 2 * cp + 1)) = fp8x8_to_bf16x8((u32x2){vreg[i].z, vreg[i].w});
            *(LAS u32x4*)(F.lds + 32768 + off_trv(rho, 2 * cp)) = fp8x8_to_bf16x8((u32x2){creg[i].x, creg[i].y}); *(LAS u32x4*)(F.lds + 32768 + off_trv(rho, 2 * cp + 1)) = fp8x8_to_bf16x8((u32x2){creg[i].z, creg[i].w}); }
        if (w == 0) { const int ln = F.lane;
            sa[ln] = spre[0]; sa[64 + ln] = spre[1]; sb_[ln] = spre[2]; sb_[64 + ln] = spre[3]; sM[ln] = fmaxf(spre[6], mst); sM[64 + ln] = fmaxf(spre[7], mst);
            sn[ln] = spre[4]; sn[64 + ln] = spre[5]; }
        { const int un = u + F.G;
          if (un < NU) { const int c2 = un % NCH, h2 = (un / NCH) % NH, b2 = un / (NCH * NH), bh2 = b2 * NH + h2, t2 = b2 * SEQ + c2 * CHK;
#pragma unroll
            for (int i = 0; i < 2; ++i) { const int cq = F.tid + NTHR * i, row = cq >> 3, cp = cq & 7; kreg[i] = P4_WS16((unsigned)WS_CV + (unsigned)((t2 + row) * NCV + CK + h2 * DH + cp * 16)); }
#pragma unroll
            for (int i = 0; i < 2; ++i) { const int cq = F.tid + NTHR * i, row = cq >> 3, cp = cq & 7;
                vreg[i] = P4_WS16((unsigned)WS_CV + (unsigned)((t2 + row) * NCV + CVV + h2 * DH + cp * 16));
                creg[i] = P4_OUT16((unsigned)CSB_OFF + (unsigned)((bh2 * NCH + c2) * (DH * DH) + row * DH + cp * 16)); }
            P4_SMALL(bh2, c2); } }
        u32x4 qf[4];
#pragma unroll
        for (int kk = 0; kk < 4; ++kk) qf[kk] = fp8x8_to_bf16x8(qraw[kk]);
        const bf16x8 q0 = __builtin_bit_cast(bf16x8, qf[0]), q1 = __builtin_bit_cast(bf16x8, qf[1]), q2 = __builtin_bit_cast(bf16x8, qf[2]), q3 = __builtin_bit_cast(bf16x8, qf[3]);
        __syncthreads();
        const int j = 16 * w + r; const float Mj = sM[j], aj = sa[j];
        float qn = 0.f;
#pragma unroll
        for (int kk = 0; kk < 4; ++kk) { float qv[8]; unpack8(qf[kk], qv);
            const f32x4 n0 = *(LAS const f32x4*)(sn + 32 * kk + 8 * q), n1 = *(LAS const f32x4*)(sn + 32 * kk + 8 * q + 4);
            qn += qv[0] * n0[0] + qv[1] * n0[1] + qv[2] * n0[2] + qv[3] * n0[3] + qv[4] * n1[0] + qv[5] * n1[1] + qv[6] * n1[2] + qv[7] * n1[3]; }
        float rs = 0.f; bf16x8 pf[4];
#pragma unroll
        for (int k2 = 0; k2 < 4; ++k2) {
            u32x4 pw = (u32x4){0u, 0u, 0u, 0u};
            if (2 * k2 <= w) {
                float pv[2][4]; f32x4 sacc[2]; const bool two = (2 * k2 + 1 <= w);
#pragma unroll
                for (int hh = 0; hh < 2; ++hh) { const int n = 2 * k2 + hh; sacc[hh] = (f32x4){0.f, 0.f, 0.f, 0.f};
                    if (hh == 0 || two) {
                        const bf16x8 k0 = *(const LAS bf16x8*)(F.lds + ak[0] + 4096 * n), k1 = *(const LAS bf16x8*)(F.lds + ak[1] + 4096 * n), k2f = *(const LAS bf16x8*)(F.lds + ak[2] + 4096 * n), k3 = *(const LAS bf16x8*)(F.lds + ak[3] + 4096 * n);
                        sacc[hh] = __builtin_amdgcn_mfma_f32_16x16x32_bf16(k0, q0, sacc[hh], 0, 0, 0); sacc[hh] = __builtin_amdgcn_mfma_f32_16x16x32_bf16(k1, q1, sacc[hh], 0, 0, 0);
                        sacc[hh] = __builtin_amdgcn_mfma_f32_16x16x32_bf16(k2f, q2, sacc[hh], 0, 0, 0); sacc[hh] = __builtin_amdgcn_mfma_f32_16x16x32_bf16(k3, q3, sacc[hh], 0, 0, 0); } }
                MFMA_DRAIN();
#pragma unroll
                for (int hh = 0; hh < 2; ++hh) { const int n = 2 * k2 + hh;
                    if (hh == 0 || two) { const f32x4 bv = *(LAS const f32x4*)(sb_ + 16 * n + 4 * q);
                        const f32x4 d4 = (bv - Mj) * 1.4426950408889634f;
                        const f32x4 e4 = (f32x4){__builtin_amdgcn_exp2f(d4[0]), __builtin_amdgcn_exp2f(d4[1]), __builtin_amdgcn_exp2f(d4[2]), __builtin_amdgcn_exp2f(d4[3])};
                        const f32x4 val4 = (sacc[hh] * 0.08838834764831845f) * e4;
#pragma unroll
                        for (int t = 0; t < 4; ++t) { float val = val4[t]; if (n == w && (4 * q + t) > r) val = 0.f; rs += val; pv[hh][t] = val; } }
                    else {
#pragma unroll
                        for (int t = 0; t < 4; ++t) pv[hh][t] = 0.f; } }
                pw.x = pk2(pv[0][0], pv[0][1]); pw.y = pk2(pv[0][2], pv[0][3]); pw.z = pk2(pv[1][0], pv[1][1]); pw.w = pk2(pv[1][2], pv[1][3]);
            }
            pf[k2] = __builtin_bit_cast(bf16x8, pw); }
        rs = sum_rows4(rs); qn = sum_rows4(qn);
        f32x4 acc[8];
#pragma unroll
        for (int vt = 0; vt < 8; ++vt) acc[vt] = (f32x4){0.f, 0.f, 0.f, 0.f};
#pragma unroll
        for (int kk = 0; kk < 4; ++kk) { const bf16x8 qb = kk == 0 ? q0 : kk == 1 ? q1 : kk == 2 ? q2 : q3;
            s16x4 cc[16];
#pragma unroll
            for (int vh = 0; vh < 2; ++vh)
#pragma unroll
                for (int i = 0; i < 4; ++i) { TR_ISSUE_OFF(cc[8 * vh + 2 * i], av[4 * vh + i], 32768 + kk * 8192); TR_ISSUE_OFF(cc[8 * vh + 2 * i + 1], av[4 * vh + i], 32768 + kk * 8192 + 4096); }
            TR_WAIT8(cc[0], cc[1], cc[2], cc[3], cc[4], cc[5], cc[6], cc[7]); TR_WAIT8(cc[8], cc[9], cc[10], cc[11], cc[12], cc[13], cc[14], cc[15]);
#pragma unroll
            for (int vt = 0; vt < 8; ++vt) acc[vt] = __builtin_amdgcn_mfma_f32_16x16x32_bf16(cat8(cc[2 * vt], cc[2 * vt + 1]), qb, acc[vt], 0, 0, 0); }
        MFMA_DRAIN();
        const float ei = __expf(mst - Mj); const float eis = ei * (1.0f / CS_SCALE);
#pragma unroll
        for (int vt = 0; vt < 8; ++vt) acc[vt] = acc[vt] * eis;
        { const int un = u + F.G;
          if (un < NU) { const int c2 = un % NCH, h2 = (un / NCH) % NH, b2 = un / (NCH * NH), t2 = b2 * SEQ + c2 * CHK;
#pragma unroll
            for (int kk = 0; kk < 4; ++kk) qraw[kk] = P4_WS8((unsigned)WS_CV + (unsigned)((t2 + 16 * w + r) * NCV + CQ + h2 * DH + 32 * kk + 8 * q)); } }
        u32x4 ogw[2];
#pragma unroll
        for (int g4 = 0; g4 < 2; ++g4) ogw[g4] = P4_WS16((unsigned)WS_CV + (unsigned)((t0 + 16 * w + r) * NCV + CO + h * DH + 64 * g4 + 16 * q));
#pragma unroll
        for (int k2 = 0; k2 < 4; ++k2) {
            if (k2 <= (w >> 1)) { s16x4 vv[16];
#pragma unroll
                for (int vh = 0; vh < 2; ++vh)
#pragma unroll
                    for (int i = 0; i < 4; ++i) { TR_ISSUE_OFF(vv[8 * vh + 2 * i], av[4 * vh + i], k2 * 8192); TR_ISSUE_OFF(vv[8 * vh + 2 * i + 1], av[4 * vh + i], k2 * 8192 + 4096); }
                TR_WAIT8(vv[0], vv[1], vv[2], vv[3], vv[4], vv[5], vv[6], vv[7]); TR_WAIT8(vv[8], vv[9], vv[10], vv[11], vv[12], vv[13], vv[14], vv[15]);
#pragma unroll
                for (int vt = 0; vt < 8; ++vt) acc[vt] = __builtin_amdgcn_mfma_f32_16x16x32_bf16(cat8(vv[2 * vt], vv[2 * vt + 1]), pf[k2], acc[vt], 0, 0, 0); } }
        MFMA_DRAIN();
        const float den = rs + ei * qn; const float inv = __builtin_amdgcn_rcpf(fmaxf(fabsf(den), __expf(-aj - Mj)));
        float s1 = 0.f;
#pragma unroll
        for (int vt = 0; vt < 8; ++vt) acc[vt] = acc[vt] * inv;
        { f32x4 s4 = acc[0];
#pragma unroll
          for (int vt = 1; vt < 8; ++vt) s4 += acc[vt];
          s1 = (s4[0] + s4[1]) + (s4[2] + s4[3]); }
        s1 = sum_rows4(s1);
        const float mean = s1 * (1.0f / DH); float s2 = 0.f;
        { f32x4 q4 = (f32x4){0.f, 0.f, 0.f, 0.f};
#pragma unroll
          for (int vt = 0; vt < 8; ++vt) { acc[vt] = acc[vt] - mean; q4 += acc[vt] * acc[vt]; }
          s2 = (q4[0] + q4[1]) + (q4[2] + q4[3]); }
        s2 = sum_rows4(s2);
        const float rstd = __builtin_amdgcn_rsqf(s2 * (1.0f / DH) + LN_EPS);
        LAS const float* gp = smg + h * DH + 4 * q; unsigned char* yp = (unsigned char*)F.out + (unsigned)((t0 + j) * D + h * DH + 16 * q);
#pragma unroll
        for (int g4 = 0; g4 < 2; ++g4) { unsigned og[4] = {ogw[g4].x, ogw[g4].y, ogw[g4].z, ogw[g4].w}; lane_row_transpose4(og);
            unsigned yw[4];
#pragma unroll
            for (int v = 0; v < 4; ++v) { const int vt = 4 * g4 + v; const f32x4 g4v = *(LAS const f32x4*)(gp + 16 * vt);
                const unsigned ow = og[v];
                const f32x4 sg = (f32x4){*(LAS const float*)((LAS const char*)slut + ((ow << 2) & 0x3fcu)), *(LAS const float*)((LAS const char*)slut + ((ow >> 6) & 0x3fcu)),
                                         *(LAS const float*)((LAS const char*)slut + ((ow >> 14) & 0x3fcu)), *(LAS const float*)((LAS const char*)slut + ((ow >> 22) & 0x3fcu))};
                const f32x4 y4 = (acc[vt] * rstd) * (g4v * sg);
                yw[v] = pack4_fp8c(y4, Y_SCALE); }
            lane_row_transpose4(yw);
            *(u32x4*)(yp + 64 * g4) = (u32x4){yw[0], yw[1], yw[2], yw[3]}; }
        __syncthreads();
    }
#undef P4_SMALL
#undef P4_WS16
#undef P4_WSF
#undef P4_WS8
#undef P4_OUT16
}

__device__ __forceinline__ void route_select(const float (&lg)[16], int& be0, int& be1, float& g0, float& g1) {
    float mx = lg[0];
#pragma unroll
    for (int e = 1; e < 16; ++e) mx = fmaxf(mx, lg[e]);
    float p[16];
#pragma unroll
    for (int e = 0; e < 16; ++e) p[e] = expf(lg[e] - mx);
    float best = -1.f, bp0 = 0.f, bp1 = 0.f; be0 = 0; be1 = 1;
#pragma unroll
    for (int g = 0; g < 4; ++g) { const float a0 = p[4 * g], a1 = p[4 * g + 1], a2 = p[4 * g + 2], a3 = p[4 * g + 3];
        int i0 = 0; float v0 = a0; if (a1 > v0) { v0 = a1; i0 = 1; } if (a2 > v0) { v0 = a2; i0 = 2; } if (a3 > v0) { v0 = a3; i0 = 3; }
        int i1 = 0; float v1 = -1.f;
        if (i0 != 0 && a0 > v1) { v1 = a0; i1 = 0; } if (i0 != 1 && a1 > v1) { v1 = a1; i1 = 1; } if (i0 != 2 && a2 > v1) { v1 = a2; i1 = 2; } if (i0 != 3 && a3 > v1) { v1 = a3; i1 = 3; }
        const float sg = v0 + v1; if (sg > best) { best = sg; be0 = 4 * g + i0; be1 = 4 * g + i1; bp0 = v0; bp1 = v1; } }
    const float inv = 1.0f / (bp0 + bp1); g0 = bp0 * inv; g1 = bp1 * inv;
}
__device__ __forceinline__ void p6_ln_router(const Ctx& F, int l, int cbank) {
    const bf16_t* PRE = (const bf16_t*)(F.ws + WS_PRE); bf16_t* X = (bf16_t*)(F.ws + WS_X);
    int* TL = (int*)(F.ws + WS_TLIST); float* GL = (float*)(F.ws + WS_GLIST);
    unsigned* CNT = (unsigned*)(F.ws + WS_CTL) + CW_CNT + 64 * cbank;
    LAS u32x4* fb = (LAS u32x4*)F.lds;
    LAS float* gt = (LAS float*)(F.lds + 65536); LAS float* bt = gt + 1024;
    LAS int* lcnt = (LAS int*)(F.lds + 73728); LAS int* lbase = lcnt + 16; LAS int* rec = (LAS int*)(F.lds + 73728 + 256);
    LAS float* lgw = (LAS float*)(F.lds + 73728 + 256 + 16384) + F.wave * 256;
    const int r = F.lane & 15, q = F.lane >> 4;
    const int rpw = (M + F.G - 1) / F.G, r0 = F.wg * rpw;
    u32x4 raw[32];
    if (F.wave < rpw / 16) { const bf16_t* rowp = PRE + (size_t)(r0 + 16 * F.wave + r) * D + 8 * q;
#pragma unroll
        for (int kk = 0; kk < 32; ++kk) raw[kk] = *(const u32x4*)(rowp + 32 * kk); }
    { const u32x4* RFB = (const u32x4*)(F.ws + WS_RFB);
#pragma unroll
      for (int j = 0; j < 8; ++j) fb[F.tid + NTHR * j] = RFB[F.tid + NTHR * j]; }
    for (int i = F.tid; i < D; i += NTHR) { gt[i] = F.ln_mix_g[(size_t)l * D + i]; bt[i] = F.ln_mix_b[(size_t)l * D + i]; }
    if (F.tid < 16) lcnt[F.tid] = 0;
    __syncthreads();
    float rb[16];
#pragma unroll
    for (int e = 0; e < 16; ++e) rb[e] = F.router_b[e];
    for (int grp = F.wave; grp < rpw / 16; grp += NWAVES) {
        const int rl0 = 16 * grp; unsigned char* xf = (unsigned char*)F.out + X1F_OFF + (size_t)(r0 + rl0 + r) * D + 8 * q;
        float s1 = 0.f, s2 = 0.f;
#pragma unroll
        for (int kk = 0; kk < 32; ++kk) { float v[8]; unpack8(raw[kk], v);
#pragma unroll
            for (int i = 0; i < 8; ++i) { s1 += v[i]; s2 += v[i] * v[i]; } }
        s1 = sum_rows4(s1); s2 = sum_rows4(s2);
        const float mean = s1 * (1.0f / D); const float rstd = __builtin_amdgcn_rsqf(fmaxf(s2 * (1.0f / D) - mean * mean, 0.f) + LN_EPS);
        if (q == 0) *(f32x2*)(F.ws + WS_RE + (size_t)(r0 + rl0 + r) * 8) = (f32x2){mean, rstd};
#pragma unroll
        for (int kk = 0; kk < 32; ++kk) asm volatile("" : "+v"(raw[kk]));
        f32x4 acc = (f32x4){0.f, 0.f, 0.f, 0.f};
#pragma unroll
        for (int kk = 0; kk < 32; ++kk) { float v[8], x1[8], xl[8]; unpack8(raw[kk], v);
            const f32x4 g0 = *(LAS const f32x4*)(gt + 32 * kk + 8 * q), g1 = *(LAS const f32x4*)(gt + 32 * kk + 8 * q + 4), b0 = *(LAS const f32x4*)(bt + 32 * kk + 8 * q), b1 = *(LAS const f32x4*)(bt + 32 * kk + 8 * q + 4);
#pragma unroll
            for (int i = 0; i < 4; ++i) { x1[i] = (v[i] - mean) * rstd * g0[i] + b0[i]; x1[4 + i] = (v[4 + i] - mean) * rstd * g1[i] + b1[i]; }
            const u32x4 hi = pack8(x1);
            { u32x2 f8; f8.x = pack4_fp8c((f32x4){x1[0], x1[1], x1[2], x1[3]}, 1.0f); f8.y = pack4_fp8c((f32x4){x1[4], x1[5], x1[6], x1[7]}, 1.0f); *(u32x2*)(xf + 32 * kk) = f8; }
            float hf[8]; unpack8(hi, hf);
#pragma unroll
            for (int i = 0; i < 8; ++i) xl[i] = x1[i] - hf[i];
            const bf16x8 ah = __builtin_bit_cast(bf16x8, hi), al = __builtin_bit_cast(bf16x8, pack8(xl));
            const bf16x8 bh = __builtin_bit_cast(bf16x8, fb[(kk * 2) * 64 + F.lane]), blo = __builtin_bit_cast(bf16x8, fb[(kk * 2 + 1) * 64 + F.lane]);
            acc = __builtin_amdgcn_mfma_f32_16x16x32_bf16(ah, bh, acc, 0, 0, 0);
            acc = __builtin_amdgcn_mfma_f32_16x16x32_bf16(al, bh, acc, 0, 0, 0);
            acc = __builtin_amdgcn_mfma_f32_16x16x32_bf16(ah, blo, acc, 0, 0, 0);
            MFMA_DRAIN(); }
        if (grp + NWAVES < rpw / 16) { const bf16_t* rowp = PRE + (size_t)(r0 + 16 * (grp + NWAVES) + r) * D + 8 * q;
#pragma unroll
            for (int kk = 0; kk < 32; ++kk) raw[kk] = *(const u32x4*)(rowp + 32 * kk); }
#pragma unroll
        for (int t = 0; t < 4; ++t) lgw[(4 * q + t) * 16 + r] = acc[t];
        LDS_WAIT(); asm volatile("" ::: "memory");
        if (F.lane < 16) {
            float lg[16];
#pragma unroll
            for (int q4 = 0; q4 < 4; ++q4) { const f32x4 t4 = *(LAS const f32x4*)(lgw + 16 * F.lane + 4 * q4); lg[4 * q4] = t4[0] + rb[4 * q4]; lg[4 * q4 + 1] = t4[1] + rb[4 * q4 + 1]; lg[4 * q4 + 2] = t4[2] + rb[4 * q4 + 2]; lg[4 * q4 + 3] = t4[3] + rb[4 * q4 + 3]; }
            int e0, e1; float g0, g1; route_select(lg, e0, e1, g0, g1);
            const int rr = rl0 + F.lane;
            const int s0 = atomicAdd((int*)lcnt + e0, 1), s1_ = atomicAdd((int*)lcnt + e1, 1);
            rec[rr * 8 + 0] = e0; rec[rr * 8 + 1] = e1; rec[rr * 8 + 2] = s0; rec[rr * 8 + 3] = s1_; rec[rr * 8 + 4] = __float_as_int(g0); rec[rr * 8 + 5] = __float_as_int(g1); }
        LDS_WAIT(); asm volatile("" ::: "memory");
    }
    __syncthreads();
    if (F.tid < 16) lbase[F.tid] = (int)__hip_atomic_fetch_add(CNT + F.tid, (unsigned)lcnt[F.tid], RLX_AGENT);
    __syncthreads();
    for (int rr = F.tid; rr < rpw; rr += NTHR) { const int m = r0 + rr; if (m >= M) break;
        const int e0 = rec[rr * 8 + 0], e1 = rec[rr * 8 + 1], s0 = lbase[e0] + rec[rr * 8 + 2], s1 = lbase[e1] + rec[rr * 8 + 3];
        TL[(size_t)e0 * M + s0] = 2 * m; TL[(size_t)e1 * M + s1] = 2 * m + 1;   GL[(size_t)e0 * M + s0] = __int_as_float(rec[rr * 8 + 4]); GL[(size_t)e1 * M + s1] = __int_as_float(rec[rr * 8 + 5]); }
}

__device__ __forceinline__ void moe_tables(const Ctx& F, int l) {
    LAS int* tab = (LAS int*)(F.lds + MISC_OFF + 64);
    unsigned* CNT = (unsigned*)(F.ws + WS_CTL) + CW_CNT + 64 * l;
    __syncthreads();
    if (F.tid < 16) tab[F.tid] = (int)__hip_atomic_load(CNT + F.tid, RLX_AGENT);
    __syncthreads();
    if (F.tid == 0) { int s = 0;
        for (int e = 0; e < 16; ++e) { tab[16 + e] = s; s += (tab[e] + 255) >> 8; }
        tab[32] = s; }
    __syncthreads();
}

__device__ __forceinline__ void ln_inplace_lds2(f32x2 (&v)[8], LAS const float* gb, int lane) {
    f32x2 s2 = v[0];
#pragma unroll
    for (int p = 1; p < 8; ++p) s2 += v[p];
    const float mean = wave_sum(s2[0] + s2[1], lane) * (1.0f / D); const f32x2 m2 = (f32x2){mean, mean}; f32x2 q2 = (f32x2){0.f, 0.f};
#pragma unroll
    for (int p = 0; p < 8; ++p) { v[p] -= m2; q2 += v[p] * v[p]; }
    const float rstd = __builtin_amdgcn_rsqf(wave_sum(q2[0] + q2[1], lane) * (1.0f / D) + LN_EPS); const f32x2 r2 = (f32x2){rstd, rstd};
#pragma unroll
    for (int hh = 0; hh < 4; ++hh) { const f32x4 g4 = *(LAS const f32x4*)(gb + hh * 256 + lane * 4), b4 = *(LAS const f32x4*)(gb + (4 + hh) * 256 + lane * 4);
        v[2 * hh] = v[2 * hh] * (r2 * (f32x2){g4[0], g4[1]}) + (f32x2){b4[0], b4[1]}; v[2 * hh + 1] = v[2 * hh + 1] * (r2 * (f32x2){g4[2], g4[3]}) + (f32x2){b4[2], b4[3]}; }
}
template <int NJ> __device__ __forceinline__ void row_dots2(const f32x2 (&v)[2][8], LAS const float* tab, int lane, float (&out)[2 * NJ]) {
#pragma unroll
    for (int j = 0; j < NJ; ++j) { f32x2 s0 = (f32x2){0.f, 0.f}, s1 = (f32x2){0.f, 0.f};
#pragma unroll
        for (int hh = 0; hh < 4; ++hh) { const f32x4 w = *(LAS const f32x4*)(tab + (j * 4 + hh) * 256 + lane * 4); const f32x2 w01 = (f32x2){w[0], w[1]}, w23 = (f32x2){w[2], w[3]};
            s0 += v[0][2 * hh] * w01; s0 += v[0][2 * hh + 1] * w23; s1 += v[1][2 * hh] * w01; s1 += v[1][2 * hh + 1] * w23; }
        out[j] = s0[0] + s0[1]; out[NJ + j] = s1[0] + s1[1]; }
}
__device__ __forceinline__ void store_row_bf16_2(bf16_t* row, int lane, const f32x2 (&v)[8]) {
    u32x4 a, b; a.x = pk2(v[0][0], v[0][1]); a.y = pk2(v[1][0], v[1][1]); a.z = pk2(v[2][0], v[2][1]); a.w = pk2(v[3][0], v[3][1]);
    b.x = pk2(v[4][0], v[4][1]); b.y = pk2(v[5][0], v[5][1]); b.z = pk2(v[6][0], v[6][1]); b.w = pk2(v[7][0], v[7][1]);
    *(u32x4*)(row + 8 * lane) = a; *(u32x4*)(row + 512 + 8 * lane) = b;
}
__device__ __forceinline__ void store_row_f32_2(float* row, int lane, const f32x2 (&v)[8]) {
#pragma unroll
    for (int j = 0; j < 2; ++j)
#pragma unroll
        for (int q = 0; q < 2; ++q) *(f32x4*)(row + 512 * j + 8 * lane + 4 * q) = (f32x4){v[4 * j + 2 * q][0], v[4 * j + 2 * q][1], v[4 * j + 2 * q + 1][0], v[4 * j + 2 * q + 1][1]};
}
__device__ __forceinline__ void p9_combine_ln(const Ctx& F, int l, bool dry) {
    bf16_t* X = (bf16_t*)(F.ws + WS_X); bf16_t* XO = dry ? (bf16_t*)(F.ws + WS_PRE) : X; float* FO = F.out; const unsigned char* YB = F.ws + WS_YB;
    float* GATES = (float*)(F.ws + WS_GATES); unsigned char* XF = F.ws + (dry ? WS_PRE + 128 * MiB - 64 * MiB : WS_XF);
    LAS float* wif = (LAS float*)F.lds;
    const bool lastl = (l == DEPTH - 1);
    LAS float* gb = (LAS float*)(F.lds + 32768);
    const int gw = F.wg * NWAVES + F.wave, NGW = F.G * NWAVES, npair = M / (2 * NGW);
    const bf16_t* PREp = (const bf16_t*)(F.ws + WS_PRE); LAS float* gm = gb + 2048;
    struct RawRows { u32x4 x[2][2]; u32x2 y[2][2][2]; f32x2 s[2]; };
    RawRows rawA, rawB;
#define P9_LOADS(it_, raw) do { _Pragma("unroll") for (int rr = 0; rr < 2; ++rr) { const size_t o_ = (size_t)(gw + NGW * (2 * (it_) + rr)) * D + 8 * F.lane; \
        raw.x[rr][0] = *(const u32x4*)(PREp + o_); raw.x[rr][1] = *(const u32x4*)(PREp + o_ + 512); raw.s[rr] = *(const f32x2*)(F.ws + WS_RE + (size_t)(gw + NGW * (2 * (it_) + rr)) * 8); \
        raw.y[rr][0][0] = *(const u32x2*)(YB + o_); raw.y[rr][0][1] = *(const u32x2*)(YB + o_ + 512); \
        raw.y[rr][1][0] = *(const u32x2*)(YB + (size_t)M * D + o_); raw.y[rr][1][1] = *(const u32x2*)(YB + (size_t)M * D + o_ + 512); } } while (0)
#define P9_XP(w_) ((f32x2){__uint_as_float((w_) << 16), __uint_as_float((w_) & 0xffff0000u)})
#define P9_COMB(dst, xw_, y0w_, y1w_, hi_, a2_, b2_) do { const f32x2 ya_ = __builtin_amdgcn_cvt_pk_f32_fp8((int)(y0w_), hi_), yb_ = __builtin_amdgcn_cvt_pk_f32_fp8((int)(y1w_), hi_); \
        dst = P9_XP(xw_) * (a2_) + ((ya_ + yb_) * (f32x2){1.0f / YB_SCALE, 1.0f / YB_SCALE} + (b2_)); } while (0)
#define P9_STEP(k_, raw) do { const int k = (k_); f32x2 v[2][8]; \
        _Pragma("unroll") for (int rr = 0; rr < 2; ++rr) \
            _Pragma("unroll") for (int j = 0; j < 2; ++j) { const u32x4 xw = raw.x[rr][j]; const u32x2 y0w = raw.y[rr][0][j], y1w = raw.y[rr][1][j]; \
                const float ar_ = ALPHA * raw.s[rr][1], mn_ = raw.s[rr][0]; f32x2 a2[4], b2[4]; \
                _Pragma("unroll") for (int hf = 0; hf < 2; ++hf) { const f32x4 g4 = *(LAS const f32x4*)(gm + (2 * j + hf) * 256 + F.lane * 4), c4 = *(LAS const f32x4*)(gm + (4 + 2 * j + hf) * 256 + F.lane * 4); \
                    a2[2 * hf] = (f32x2){g4[0], g4[1]} * ar_; a2[2 * hf + 1] = (f32x2){g4[2], g4[3]} * ar_; b2[2 * hf] = (f32x2){c4[0], c4[1]} - a2[2 * hf] * mn_; b2[2 * hf + 1] = (f32x2){c4[2], c4[3]} - a2[2 * hf + 1] * mn_; } \
                P9_COMB(v[rr][4 * j], xw.x, y0w.x, y1w.x, false, a2[0], b2[0]); P9_COMB(v[rr][4 * j + 1], xw.y, y0w.x, y1w.x, true, a2[1], b2[1]); \
                P9_COMB(v[rr][4 * j + 2], xw.z, y0w.y, y1w.y, false, a2[2], b2[2]); P9_COMB(v[rr][4 * j + 3], xw.w, y0w.y, y1w.y, true, a2[3], b2[3]); } \
        if (k + 2 < npair) P9_LOADS(k + 2, raw); \
        _Pragma("unroll") for (int rr = 0; rr < 2; ++rr) { const int m = gw + NGW * (2 * k + rr); ln_inplace_lds2(v[rr], gb, F.lane); \
            if (lastl) store_row_f32_2(FO + (size_t)m * D, F.lane, v[rr]); else { store_row_bf16_2(XO + (size_t)m * D, F.lane, v[rr]); \
                _Pragma("unroll") for (int j = 0; j < 2; ++j) { u32x2 f8; f8.x = pack4_fp8c((f32x4){v[rr][4 * j][0], v[rr][4 * j][1], v[rr][4 * j + 1][0], v[rr][4 * j + 1][1]}, 1.0f); f8.y = pack4_fp8c((f32x4){v[rr][4 * j + 2][0], v[rr][4 * j + 2][1], v[rr][4 * j + 3][0], v[rr][4 * j + 3][1]}, 1.0f); \
                    *(u32x2*)(XF + (size_t)m * D + 512 * j + 8 * F.lane) = f8; } } } \
        if (!lastl) { float part[16]; row_dots2<8>(v, wif, F.lane, part); \
            const float tot = reduce16(part, F.lane); \
            if ((F.lane & 3) == 0) { const int ix = idx16(F.lane), rr = ix >> 3, j = ix & 7; GATES[(size_t)(gw + NGW * (2 * k + rr)) * 8 + j] = tot + F.b_in[(size_t)(l + 1) * PIN + SRC_IF + j]; } } } while (0)
    P9_LOADS(0, rawA); P9_LOADS(1, rawB);
    if (!lastl) { const f32x4* src = (const f32x4*)(F.ws + WS_WIFP) + (size_t)(l + 1) * 2 * D;
#pragma unroll
        for (int j = 0; j < 4; ++j) *(LAS f32x4*)(wif + 4 * (F.tid + NTHR * j)) = src[F.tid + NTHR * j]; }
    for (int k = F.tid; k < D; k += NTHR) { gb[wperm_idx(0, k)] = F.ln_moe_g[(size_t)l * D + k]; gb[wperm_idx(1, k)] = F.ln_moe_b[(size_t)l * D + k]; }
    for (int k = F.tid; k < D; k += NTHR) { gm[wperm_idx(0, k)] = F.ln_mix_g[(size_t)l * D + k]; gm[wperm_idx(1, k)] = ALPHA * F.ln_mix_b[(size_t)l * D + k]; }
    __syncthreads();
    for (int it = 0; it < npair; it += 2) { P9_STEP(it, rawA); P9_STEP(it + 1, rawB); }
#undef P9_LOADS
#undef P9_XP
#undef P9_COMB
#undef P9_STEP
}

__global__ void __launch_bounds__(NTHR, 2) fwd(Args args) {
    extern __shared__ __attribute__((aligned(16))) unsigned char lds_raw[];
    Ctx F;
    F.lds = (LAS unsigned char*)lds_raw;
    F.tid = threadIdx.x; F.lane = F.tid & 63; F.wave = __builtin_amdgcn_readfirstlane(F.tid >> 6); F.G = gridDim.x; F.wg = blockIdx.x;
typedef unsigned long long u64x8 __attribute__((ext_vector_type(8)));
    typedef unsigned long long u64x2 __attribute__((ext_vector_type(2)));
#define PTRG(T, v) ((T)(GAS T)(v))
#define REFRESH() do { F.tid = opaque_tid(); F.lane = F.tid & 63; F.wave = __builtin_amdgcn_readfirstlane(F.tid >> 6); \
        u64x8 _a, _b; u64x2 _c; \
        asm volatile("s_load_dwordx16 %0, %3, 0x0\n\ts_load_dwordx16 %1, %3, 0x40\n\ts_load_dwordx4 %2, %3, 0x80\n\ts_waitcnt lgkmcnt(0)" : "=&s"(_a), "=&s"(_b), "=&s"(_c) : "s"(__builtin_amdgcn_kernarg_segment_ptr())); \
        F.x = PTRG(const float*, _a[0]); F.w_in = PTRG(const float*, _a[1]); F.b_in = PTRG(const float*, _a[2]); F.conv_w = PTRG(const float*, _a[3]); F.mh_g = PTRG(const float*, _a[4]); F.w_out = PTRG(const float*, _a[5]); \
        F.ln_mix_g = PTRG(const float*, _a[6]); F.ln_mix_b = PTRG(const float*, _a[7]); F.router_w = PTRG(const float*, _b[0]); F.router_b = PTRG(const float*, _b[1]); F.w_gate = PTRG(const float*, _b[2]); F.w_up = PTRG(const float*, _b[3]); \
        F.w_down = PTRG(const float*, _b[4]); F.ln_moe_g = PTRG(const float*, _b[5]); F.ln_moe_b = PTRG(const float*, _b[6]); F.out = PTRG(float*, _b[7]); F.ws = PTRG(unsigned char*, _c[0]); } while (0)
    F.x = args.in[0]; F.w_in = args.in[1]; F.b_in = args.in[2]; F.conv_w = args.in[3]; F.mh_g = args.in[4]; F.w_out = args.in[5]; F.ln_mix_g = args.in[6]; F.ln_mix_b = args.in[7];
    F.router_w = args.in[8]; F.router_b = args.in[9]; F.w_gate = args.in[10]; F.w_up = args.in[11]; F.w_down = args.in[12]; F.ln_moe_g = args.in[13]; F.ln_moe_b = args.in[14];
    F.out = args.out; F.ws = args.ws;
    for (int u = F.tid; u < (LDS_BYTES - MISC_OFF) / 4; u += NTHR) ((LAS unsigned*)(F.lds + MISC_OFF))[u] = 0u;
    __syncthreads();
    XcdBarrier bar; bar.bar = (unsigned*)(F.ws + WS_CTL) + CW_BAR + args.li * XCD_BAR_WORDS; bar.x = 0; bar.st = (volatile LAS unsigned*)(F.lds + MISC_OFF);
    const int lo = args.ph_lo, hi = args.ph_hi;
    if (hi - lo > 1) bar = xcd_barrier_post((unsigned*)(F.ws + WS_CTL) + CW_BAR + args.li * XCD_BAR_WORDS, (volatile LAS unsigned*)(F.lds + MISC_OFF));
#define IN(k) (lo <= (k) && (k) < hi)
#define SEAM(k) do { if (IN(k) && IN((k) + 1)) xcd_barrier(bar); } while (0)
    LAS const int* tab = (LAS const int*)(F.lds + MISC_OFF + 64);
    LAS int* toks = (LAS int*)(F.lds + TOK_OFF);

    if (EN(0) && IN(0))
#pragma unroll 1
    for (int rep = 0; rep < REPS(0); ++rep) { REFRESH(); p0_prologue(F); __syncthreads(); }
    SEAM(0);
    for (int l = 0; l < DEPTH; ++l) {
        const int pb = 1 + 9 * l;
        if (EN(1) && IN(pb + 0))
#pragma unroll 1
        for (int rep = 0; rep < REPS(1); ++rep) {
            REFRESH();
            pg8::DenseOrder S; S.nM = M / 256; S.nN = NP / 256; S.nwg = S.nM * S.nN; S.G = F.G; S.c = F.wg; S.lda = D / 2; S.K = D / 2; S.Bt = (const bf16_t*)(F.ws + WS_WIN) + (size_t)l * NP * (D / 2);
            { LAS float* bl = (LAS float*)(F.lds + BIAS_OFF); const float* bsrc = F.b_in + (size_t)l * PIN;
              for (int i = F.tid; i < NP; i += NTHR) bl[i] = bsrc[win_src_col(i)];
              __syncthreads(); }
            pg8::EpiInProj E{(bf16_t*)(F.ws + WS_P), F.ws + WS_CV, (LAS const float*)(F.lds + BIAS_OFF)};
            pg8::gemm_phase<pg8::EpiInProj, pg8::DenseOrder>(F.lds, (const bf16_t*)(F.ws + WS_XF), S, E);
        }
        SEAM(pb + 0);
        if (EN(2) && IN(pb + 1))
#pragma unroll 1
        for (int rep = 0; rep < REPS(2); ++rep) { REFRESH(); p2_local_conv(F, l); }
        SEAM(pb + 1);
        if (EN(3) && IN(pb + 2))
#pragma unroll 1
        for (int rep = 0; rep < REPS(3); ++rep) { REFRESH(); p3_scan(F); }
        SEAM(pb + 2);
        if (EN(4) && IN(pb + 3))
#pragma unroll 1
        for (int rep = 0; rep < REPS(4); ++rep) { REFRESH(); p4_mlstm_out(F, l); }
        SEAM(pb + 3);
        if (EN(5) && IN(pb + 4))
#pragma unroll 1
        for (int rep = 0; rep < REPS(5); ++rep) {
            REFRESH();
            pg8::DenseOrder S; S.nM = M / 256; S.nN = D / 256; S.nwg = S.nM * S.nN; S.G = F.G; S.c = F.wg; S.lda = D / 2; S.K = D / 2; S.Bt = (const bf16_t*)(F.ws + WS_WOUT) + (size_t)l * D * (D / 2);
            pg8::EpiOutProj E{(bf16_t*)(F.ws + WS_PRE), (const bf16_t*)(F.ws + WS_X)};
            pg8::gemm_phase<pg8::EpiOutProj, pg8::DenseOrder>(F.lds, (const bf16_t*)F.out, S, E);
        }
        SEAM(pb + 4);
        if (EN(6) && IN(pb + 5))
#pragma unroll 1
        for (int rep = REPS(6) - 1; rep >= 0; --rep) { REFRESH(); p6_ln_router(F, l, l + 4 * rep); __syncthreads(); }
        SEAM(pb + 5);
        if (EN(7) && IN(pb + 6))
#pragma unroll 1
        for (int pass = 0; pass < 2; ++pass) {
            REFRESH();
            if (pass == 0) moe_tables(F, l);
            const int nwg7 = __builtin_amdgcn_readfirstlane(tab[32]) * 4, R7 = nwg7 / F.G, L7 = nwg7 - R7 * F.G;
            if (pass == 0 || F.wg < L7) {
                pg8::MoeOrder<true> S; S.nM = tab[32]; S.nN = 4; S.nwg = nwg7; S.G = F.G; S.c = F.wg; S.lda = D / 2; S.K = D / 2; S.Bt = (const bf16_t*)(F.ws + WS_WGU) + (size_t)l * NE * 1024 * (D / 2); S.estride = (size_t)1024 * (D / 2); S.tab = tab; S.toks = toks;
                S.i0 = pass ? R7 : 0; S.ni = pass ? 1 : R7; S.L = 0; S.lmask = (LAS const unsigned*)(F.lds + MISC_OFF + 256); S.left = (unsigned*)(F.ws + WS_CTL) + CW_LEFT + l;
                const int* TL = (const int*)(F.ws + WS_TLIST);
                { int vals[MAXU / 2];
#pragma unroll
                  for (int j = 0; j < MAXU / 2; ++j) { pg8::Unit u{0, 0, 0, 0, 0}; const bool ok = S.next(2 * j + (F.tid >> 8), u); const int slot = u.rb * 256 + (F.tid & 255); const bool live = ok && slot < tab[u.e];
                      const int v = TL[live ? (size_t)u.e * M + slot : (size_t)0]; vals[j] = live ? (v >> 1) : 0; }
#pragma unroll
                  for (int j = 0; j < MAXU / 2; ++j) toks[(2 * j + (F.tid >> 8)) * 256 + (F.tid & 255)] = vals[j]; }
                __syncthreads();
                pg8::EpiGateUp E{F.ws + WS_HDN};
                pg8::gemm_phase<pg8::EpiGateUp, pg8::MoeOrder<true>>(F.lds, (const bf16_t*)((const unsigned char*)F.out + X1F_OFF), S, E);
                if (pass) {
                    VM_WAIT(); __syncthreads();
                    if (F.tid == 0) { __builtin_amdgcn_fence(__ATOMIC_RELEASE, "agent"); VM_WAIT(); (void)xb_add((unsigned*)(F.ws + WS_CTL) + CW_LEFT + l, 1u); }
                }
            }
            if (pass == 0) SEAM(pb + 6);
        }
        if (EN(8) && IN(pb + 7))
#pragma unroll 1
        for (int rep = 0; rep < REPS(8); ++rep) {
            REFRESH();
            if (MK_PER_PHASE) moe_tables(F, l);
            const int nwg7 = __builtin_amdgcn_readfirstlane(tab[32]) * 4, R7 = nwg7 / F.G, L7 = nwg7 - R7 * F.G;
            { LAS unsigned* lm = (LAS unsigned*)(F.lds + MISC_OFF + 256);
              __syncthreads();
              if (F.tid < 32) lm[F.tid] = 0u;
              __syncthreads();
              if (F.tid < L7) { pg8::Unit u{0, 0, 0, 0, 0}; pg8::static_unit(tab[32], 4, R7 * F.G + F.tid, u); atomicOr((unsigned*)(lm + (u.pm >> 5)), 1u << (u.pm & 31)); }
              __syncthreads(); }
            pg8::MoeOrder<false> S; S.nM = tab[32]; S.nN = 4; S.nwg = S.nM * 4; S.G = F.G; S.c = F.wg; S.lda = DFF / 2; S.K = DFF / 2; S.Bt = (const bf16_t*)(F.ws + WS_WDN) + (size_t)l * NE * D * (DFF / 2); S.estride = (size_t)D * (DFF / 2); S.tab = tab; S.toks = toks;
            S.i0 = 0; S.ni = 0; S.L = L7; S.lmask = (LAS const unsigned*)(F.lds + MISC_OFF + 256); S.left = (unsigned*)(F.ws + WS_CTL) + CW_LEFT + l;
            { const float* GLp = (const float*)(F.ws + WS_GLIST); LAS float* gts = (LAS float*)(F.lds + TOK_OFF);
              const int* TLp = (const int*)(F.ws + WS_TLIST); LAS int* dsts = (LAS int*)(F.lds + BIAS_OFF);
              float vals[MAXU / 2]; int dv[MAXU / 2];
#pragma unroll
              for (int j = 0; j < MAXU / 2; ++j) { pg8::Unit u{0, 0, 0, 0, 0}; const bool ok = S.next(2 * j + (F.tid >> 8), u); const int slot = u.rb * 256 + (F.tid & 255); const bool live = ok && slot < tab[u.e];
                  const float v = GLp[live ? (size_t)u.e * M + slot : (size_t)0]; const int d = TLp[live ? (size_t)u.e * M + slot : (size_t)0]; vals[j] = live ? v : 0.f; dv[j] = live ? d : -1; }
#pragma unroll
              for (int j = 0; j < MAXU / 2; ++j) { gts[(2 * j + (F.tid >> 8)) * 256 + (F.tid & 255)] = vals[j]; dsts[(2 * j + (F.tid >> 8)) * 256 + (F.tid & 255)] = dv[j]; }
              __syncthreads(); }
            pg8::EpiDown E{F.ws + WS_YB, (LAS const float*)(F.lds + TOK_OFF), (LAS const int*)(F.lds + BIAS_OFF)};
            pg8::gemm_phase<pg8::EpiDown, pg8::MoeOrder<false>>(F.lds, (const bf16_t*)(F.ws + WS_HDN), S, E);
        }
        SEAM(pb + 7);
        if (EN(9) && IN(pb + 8))
#pragma unroll 1
        for (int rep = REPS(9) - 1; rep >= 0; --rep) { REFRESH(); p9_combine_ln(F, l, rep != 0); __syncthreads(); }
        SEAM(pb + 8);
    }
#undef IN
#undef SEAM
}

extern "C" void kernel_launch(void* const* d_in, const int* in_sizes, int n_in, void* d_out, int out_size, void* d_ws, size_t ws_size, hipStream_t stream) {
    static int grid = 0;
    if (grid == 0) {
        if (n_in != 15 || in_sizes[0] != M * D || out_size != M * D || ws_size < WS_END) { fprintf(stderr, "kernel_launch: unexpected shapes (n_in %d, in0 %d, out %d, ws %zu)\n", n_in, n_in > 0 ? in_sizes[0] : -1, out_size, ws_size); grid = -1; return; }
        int dev = 0, cus = 0, per_cu = 0;
        if (hipGetDevice(&dev) != hipSuccess || hipDeviceGetAttribute(&cus, hipDeviceAttributeMultiprocessorCount, dev) != hipSuccess) { grid = -1; return; }
        if (hipFuncSetAttribute((const void*)fwd, hipFuncAttributeMaxDynamicSharedMemorySize, LDS_BYTES) != hipSuccess) { fprintf(stderr, "kernel_launch: hipFuncSetAttribute failed\n"); grid = -1; return; }
        if (hipOccupancyMaxActiveBlocksPerMultiprocessor(&per_cu, (const void*)fwd, NTHR, LDS_BYTES) != hipSuccess || per_cu < 1) fprintf(stderr, "kernel_launch: occupancy query says %d\n", per_cu);
        (void)hipGetLastError();
        grid = cus;
        if (grid > 256) grid = 256;
        if (grid != 256) { fprintf(stderr, "kernel_launch: %d CUs: this kernel is sized for 256\n", grid); grid = -1; return; }
    }
    if (grid < 0) return;
    if (hipMemsetAsync((char*)d_ws + WS_CTL, 0, CTL_ZERO_BYTES, stream) != hipSuccess) return;
    Args a{};
    for (int i = 0; i < 15; ++i) a.in[i] = (const float*)d_in[i];
    a.out = (float*)d_out; a.ws = (unsigned char*)d_ws; a.pad = 0;
#if MK_PER_PHASE
    for (int p = 0; p < NPHASE; ++p) { a.ph_lo = p; a.ph_hi = p + 1; a.li = 0; hipLaunchKernelGGL(fwd, dim3(grid), dim3(NTHR), LDS_BYTES, stream, a); }
#else
    a.ph_lo = 0; a.ph_hi = NPHASE; a.li = 0;
    hipLaunchKernelGGL(fwd, dim3(grid), dim3(NTHR), LDS_BYTES, stream, a);
#endif
}
```

```cpp
#include <hip/hip_runtime.h>
#include <cstdio>
#include <cstdint>

#ifndef MK_PER_PHASE
#define MK_PER_PHASE 0
#endif
#ifndef PH_MASK
#define PH_MASK 0x3ff
#endif
#define EN(k) (((PH_MASK) >> (k)) & 1)
#ifndef REP_MASK
#define REP_MASK 0
#endif
#define REPS(k) (1 + (((REP_MASK) >> (k)) & 1))

#define LAS __attribute__((address_space(3)))
#define GAS __attribute__((address_space(1)))
typedef unsigned short bf16_t;
typedef short bf16x8 __attribute__((ext_vector_type(8)));
typedef float f32x4 __attribute__((ext_vector_type(4)));
typedef float f32x2 __attribute__((ext_vector_type(2)));
typedef int i32x8v __attribute__((ext_vector_type(8)));
typedef float f32x8v __attribute__((ext_vector_type(8)));
typedef unsigned u32x4 __attribute__((ext_vector_type(4)));
typedef unsigned u32x2 __attribute__((ext_vector_type(2)));
#define RLX_AGENT __ATOMIC_RELAXED, __HIP_MEMORY_SCOPE_AGENT
#define LDS_WAIT() asm volatile("s_waitcnt lgkmcnt(0)" ::: "memory")
#define VM_WAIT() asm volatile("s_waitcnt vmcnt(0)" ::: "memory")

constexpr int D = 1024, NB = 8, SEQ = 8192, M = NB * SEQ, DEPTH = 4;
constexpr int NH = 4, DH = 128, CHK = 128, NCH = SEQ / CHK;
constexpr int PIN = 3592;
constexpr int NP = 3584;
constexpr int NPB = 1024;
constexpr int PQ = 0, PK = 512;
constexpr int NCV = 3072;
constexpr int CGB = 0, CU = 512, CO = 1024, CVV = 1536, CQ = 2048, CK = 2560;
__host__ __device__ __forceinline__ int win_src_col(int n) {
    const int grp = n >> 9;
    if (grp >= 5) { const int w = n & 255, t = (n - 2560) >> 8; return (((w >> 5) & 1) ? 3080 : 2568) + t * 128 + (w >> 6) * 32 + (w & 31); }
    return (grp == 0 ? 0 : grp == 1 ? 2056 : grp == 2 ? 512 : grp == 3 ? 1024 : 1536) + (n & 511);
}
constexpr int SRC_IF = 2048;
constexpr int NE = 16, DFF = 512;
constexpr int MAXROWS = 2 * M + NE * 256;
constexpr float ALPHA = 1.6817928305074290f, LN_EPS = 1e-5f;
constexpr float YB_SCALE = 8.0f;
constexpr int NWAVES = 8, NTHR = 512;
constexpr int NPHASE = 1 + DEPTH * 9;

constexpr size_t MiB = (size_t)1 << 20;
constexpr size_t WS_CTL = 0, CTL_ZERO_BYTES = MK_PER_PHASE ? 2 * MiB : 32768;
constexpr size_t WS_RFB = 2 * MiB;
constexpr size_t WS_WIFP = 2 * MiB + 65536;
constexpr size_t WS_GATES = 3 * MiB;
constexpr size_t WS_AA = 5 * MiB;
constexpr size_t WS_BB = 6 * MiB;
constexpr size_t WS_NL = 7 * MiB;
constexpr size_t WS_ML = 8 * MiB;
constexpr size_t WS_GC = 8 * MiB + 8192;
constexpr size_t WS_MST = 8 * MiB + 16384;
constexpr size_t WS_RE = 9 * MiB;
constexpr size_t WS_RS = 9 * MiB + 512 * 1024;
constexpr size_t WS_NST = 10 * MiB;
constexpr size_t WS_TLIST = 11 * MiB;
constexpr size_t WS_GLIST = 15 * MiB;
constexpr size_t WS_PM = 19 * MiB;
constexpr size_t WS_WIN = 20 * MiB;
constexpr size_t WS_WOUT = 48 * MiB;
constexpr size_t WS_WGU = 56 * MiB;
constexpr size_t WS_WDN = 184 * MiB;
constexpr size_t WS_X = 248 * MiB;
constexpr size_t WS_CS = 376 * MiB;
constexpr size_t WS_PRE = WS_CS;
constexpr size_t WS_P = 504 * MiB;
constexpr size_t WS_CV = 504 * MiB + 128 * MiB;
constexpr size_t WS_XF = WS_P;
constexpr size_t WS_HDN = WS_P;
constexpr size_t WS_YB = 640 * MiB;
constexpr size_t WS_END = 952 * MiB;
constexpr size_t X1F_OFF = 160 * MiB;
constexpr size_t CSB_OFF = 128 * MiB;
static_assert(WS_CV + (size_t)M * NCV <= WS_END, "ws map: CV");
static_assert(WS_HDN + (size_t)MAXROWS * DFF * 2 <= WS_YB && WS_YB + (size_t)MAXROWS * D * 2 <= WS_END && WS_P + (size_t)M * NP * 2 <= WS_END, "ws map");
constexpr int CW_CNT = 64;
constexpr int CW_LEFT = 1024;
constexpr int CW_BAR = 4096;
constexpr int SCR_BYTES = 131072;
constexpr int MISC_OFF = SCR_BYTES;
constexpr int TOK_OFF = MISC_OFF + 1024, MAXU = 12;
constexpr int BIAS_OFF = 147456;
constexpr int LDS_BYTES = 163840;
static_assert(TOK_OFF + MAXU * 256 * 4 <= BIAS_OFF && BIAS_OFF + NP * 4 <= LDS_BYTES, "lds map");

__device__ __forceinline__ int opaque_tid() { int t = threadIdx.x; asm volatile("" : "+v"(t)); return t; }
__device__ __forceinline__ float bf2f(unsigned b) { return __uint_as_float(b << 16); }
__device__ __forceinline__ unsigned pk2(float lo, float hi) { unsigned r; asm volatile("v_cvt_pk_bf16_f32 %0, %1, %2" : "=v"(r) : "v"(lo), "v"(hi)); return r; }
__device__ __forceinline__ unsigned pack4_fp8c(const f32x4 v, float scale) {
    const f32x4 sv = v * scale;
    const float a = __builtin_amdgcn_fmed3f(sv[0], -400.f, 400.f), b = __builtin_amdgcn_fmed3f(sv[1], -400.f, 400.f), c = __builtin_amdgcn_fmed3f(sv[2], -400.f, 400.f), d = __builtin_amdgcn_fmed3f(sv[3], -400.f, 400.f);
    int w = __builtin_amdgcn_cvt_pk_fp8_f32(a, b, 0, false); w = __builtin_amdgcn_cvt_pk_fp8_f32(c, d, w, true); return (unsigned)w; }
__device__ __forceinline__ f32x4 unpack4_fp8(unsigned w) { const f32x2 lo = __builtin_amdgcn_cvt_pk_f32_fp8((int)w, false), hi = __builtin_amdgcn_cvt_pk_f32_fp8((int)w, true); return (f32x4){lo[0], lo[1], hi[0], hi[1]}; }
__device__ __forceinline__ u32x4 fp8x8_to_bf16x8(const u32x2 w) { const f32x4 a = unpack4_fp8(w.x), b = unpack4_fp8(w.y); u32x4 o; o.x = pk2(a[0], a[1]); o.y = pk2(a[2], a[3]); o.z = pk2(b[0], b[1]); o.w = pk2(b[2], b[3]); return o; }
__device__ __forceinline__ u32x4 widen_fp8_pair(const u32x2 a, const u32x2 b) {
    const auto r0 = __builtin_amdgcn_permlane16_swap(a.x, b.x, false, false); const auto r1 = __builtin_amdgcn_permlane16_swap(a.y, b.y, false, false);
    u32x4 w; w.x = r0[0]; w.y = r1[0]; w.z = r0[1]; w.w = r1[1]; return w; }
__device__ __forceinline__ void lane_row_transpose4(unsigned (&x)[4]) {
    const auto a = __builtin_amdgcn_permlane16_swap(x[0], x[1], false, false), b = __builtin_amdgcn_permlane16_swap(x[2], x[3], false, false);
    const auto c = __builtin_amdgcn_permlane32_swap(a[0], b[0], false, false), d = __builtin_amdgcn_permlane32_swap(a[1], b[1], false, false);
    x[0] = c[0]; x[1] = d[0]; x[2] = c[1]; x[3] = d[1];
}
constexpr float WGU_SCALE = 32.0f, WDN_SCALE = 64.0f, H_SCALE = 4.0f, WOUT_SCALE = 64.0f, Y_SCALE = 8.0f, WIN_SCALE = 32.0f;
constexpr float CL_SCALE = 16.0f, CS_SCALE = 8.0f;
#define MFMA_DRAIN() do { __builtin_amdgcn_sched_barrier(0); asm volatile("s_nop 15\n\ts_nop 15" ::: "memory"); __builtin_amdgcn_sched_barrier(0); } while (0)
__device__ __forceinline__ void unpack8(const u32x4 w, float (&f)[8]) {
    f[0] = __uint_as_float(w.x << 16); f[1] = __uint_as_float(w.x & 0xffff0000u); f[2] = __uint_as_float(w.y << 16); f[3] = __uint_as_float(w.y & 0xffff0000u);
    f[4] = __uint_as_float(w.z << 16); f[5] = __uint_as_float(w.z & 0xffff0000u); f[6] = __uint_as_float(w.w << 16); f[7] = __uint_as_float(w.w & 0xffff0000u);
}
__device__ __forceinline__ u32x4 pack8(const float (&f)[8]) { u32x4 w; w.x = pk2(f[0], f[1]); w.y = pk2(f[2], f[3]); w.z = pk2(f[4], f[5]); w.w = pk2(f[6], f[7]); return w; }
__device__ __forceinline__ float shx(float v, int mask, int lane) { return __int_as_float(__builtin_amdgcn_ds_bpermute((lane ^ mask) << 2, __float_as_int(v))); }
__device__ __forceinline__ float shup(float v, int d, int lane) { return __int_as_float(__builtin_amdgcn_ds_bpermute((lane - d) << 2, __float_as_int(v))); }
__device__ __forceinline__ float rdlane(float v, int src) { return __int_as_float(__builtin_amdgcn_readlane(__float_as_int(v), src)); }
template <int CTRL> __device__ __forceinline__ float dpp_mov(float v) { return __int_as_float(__builtin_amdgcn_update_dpp(0, __float_as_int(v), CTRL, 0xF, 0xF, true)); }
__device__ __forceinline__ float row_sum16(float v) { v += dpp_mov<0xB1>(v); v += dpp_mov<0x4E>(v); v += dpp_mov<0x141>(v); v += dpp_mov<0x140>(v); return v; }
__device__ __forceinline__ float wave_sum(float v, int) { v = row_sum16(v); return (rdlane(v, 0) + rdlane(v, 16)) + (rdlane(v, 32) + rdlane(v, 48)); }
__device__ __forceinline__ float sum_rows4(float v) {
    const auto a = __builtin_amdgcn_permlane32_swap(__float_as_uint(v), __float_as_uint(v), false, false); v = __uint_as_float(a[0]) + __uint_as_float(a[1]);
    const auto b = __builtin_amdgcn_permlane16_swap(__float_as_uint(v), __float_as_uint(v), false, false); return __uint_as_float(b[0]) + __uint_as_float(b[1]);
}
__device__ __forceinline__ float wave_max(float v, int lane) {
#pragma unroll
    for (int o = 1; o < 64; o <<= 1) v = fmaxf(v, shx(v, o, lane));
    return v;
}
__device__ __forceinline__ float sigmoidf_(float x) { return __builtin_amdgcn_rcpf(1.0f + __expf(-x)); }

#define XB_TMO      128
#define XB_XCNT(j)  (256  + 64 * (j))
#define XB_XSUB(j)  (1280 + 64 * (j))
#define XB_XGEN(j)  (2304 + 64 * (j))
#define XB_TOP      3328
#define XB_TOPGEN   3392
#define XCD_BAR_WORDS 3456
#define XB_SPIN_CAP (1u << 18)
static_assert(MK_PER_PHASE || (size_t)(CW_BAR + XCD_BAR_WORDS) * 4 <= CTL_ZERO_BYTES, "control words");
__device__ __forceinline__ unsigned xb_ld(unsigned* p)              { return __hip_atomic_load(p, __ATOMIC_RELAXED, __HIP_MEMORY_SCOPE_AGENT); }
__device__ __forceinline__ unsigned xb_add(unsigned* p, unsigned v) { return __hip_atomic_fetch_add(p, v, __ATOMIC_RELAXED, __HIP_MEMORY_SCOPE_AGENT); }
__device__ __forceinline__ unsigned xb_xcc_id() { return (unsigned)__builtin_amdgcn_s_getreg((3 << 11) | 20) & 0xFu; }
#define XB_SPIN(cond, bar) do { unsigned _sp = 0; while (cond) { __builtin_amdgcn_s_sleep(1); \
    if ((++_sp & 255u) == 0u) { if (xb_ld(&(bar)[XB_TMO])) break; if (_sp > XB_SPIN_CAP) { atomicAdd(&(bar)[XB_TMO], 1u); break; } } } } while (0)
struct XcdBarrier { unsigned* bar; unsigned x; volatile LAS unsigned* st; };
__device__ __forceinline__ XcdBarrier xcd_barrier_post(unsigned* bar, volatile LAS unsigned* st) {
    XcdBarrier b; b.bar = bar; b.x = xb_xcc_id(); b.st = st;
    if (threadIdx.x == 0) (void)xb_add(&bar[XB_XCNT(b.x)], 1u);
    return b;
}
__device__ __forceinline__ void xcd_barrier_complete(unsigned* bar, unsigned x, unsigned& nloc, unsigned& nx) {
    const unsigned G = gridDim.x * gridDim.y * gridDim.z;
    unsigned sum, cnt, mine, sp = 0u;
    for (;;) {
        sum = 0u; cnt = 0u; mine = 0u;
#pragma unroll
        for (unsigned j = 0; j < 16; ++j) { const unsigned c = xb_ld(&bar[XB_XCNT(j)]); sum += c; cnt += (c > 0u) ? 1u : 0u; mine = (j == x) ? c : mine; }
        if (sum == G) break;
        __builtin_amdgcn_s_sleep(1);
        if ((++sp & 255u) == 0u) { if (xb_ld(&bar[XB_TMO])) break; if (sp > XB_SPIN_CAP) { atomicAdd(&bar[XB_TMO], 1u); break; } }
    }
    nloc = mine > 0u ? mine : 1u; nx = cnt > 0u ? cnt : 1u;
}
__device__ __forceinline__ void xcd_barrier(const XcdBarrier& b) {
    asm volatile("s_waitcnt vmcnt(0)" ::: "memory");
    __syncthreads();
    if (threadIdx.x == 0) {
        unsigned* bar = b.bar;
        __builtin_amdgcn_s_waitcnt(0);
        unsigned nloc = b.st[0], nx = b.st[1];
        if (nloc == 0u) { xcd_barrier_complete(bar, b.x, nloc, nx); b.st[0] = nloc; b.st[1] = nx; }
        const unsigned old = xb_add(&bar[XB_XSUB(b.x)], 1u);
        const unsigned gen = old / nloc;
        if (old + 1u == (gen + 1u) * nloc) {
            __builtin_amdgcn_fence(__ATOMIC_RELEASE, "agent");
            asm volatile("s_waitcnt vmcnt(0)" ::: "memory");
            const unsigned og = xb_add(&bar[XB_TOP], 1u);
            const unsigned tg = og / nx;
            if (og + 1u == (tg + 1u) * nx) xb_add(&bar[XB_TOPGEN], 1u);
            else XB_SPIN(xb_ld(&bar[XB_TOPGEN]) == tg, bar);
            __builtin_amdgcn_fence(__ATOMIC_ACQUIRE, "agent");
            xb_add(&bar[XB_XGEN(b.x)], 1u);
            asm volatile("s_waitcnt vmcnt(0)" ::: "memory");
        } else {
            XB_SPIN(xb_ld(&bar[XB_XGEN(b.x)]) == gen, bar);
            __builtin_amdgcn_fence(__ATOMIC_ACQUIRE, "agent");
            asm volatile("s_waitcnt vmcnt(0)" ::: "memory");
        }
    }
    __syncthreads();
}

namespace pg8 {
constexpr int BM = 256, BK = 64, HALF = 128, HTB = HALF * BK * 2, STAGE_BYTES = 8 * HTB, NXCD = 8, WGM = 4;
__host__ __device__ __forceinline__ int lds_byte(int r, int c) { const int st = (r >> 4) * 2 + (c >> 5), rr = r & 15, cc = c & 31, ob = rr * 64 + cc * 2; return st * 1024 + (ob ^ (((ob >> 9) & 1) << 5)); }
__host__ __device__ __forceinline__ void stage_rc(int b, int& R, int& C) { const int st = b / 1024, sb = b % 1024, swz = sb ^ (((sb >> 9) & 1) << 5); R = (st >> 1) * 16 + swz / 64; C = (st & 1) * 32 + (swz % 64) / 2; }
__host__ __device__ __forceinline__ int perm32(int rho) { const int n = rho >> 4, i = rho & 15; return 8 * (i >> 2) + 4 * n + (i & 3); }

struct Unit { int pm, pn, e, rb, ui; };

__device__ __forceinline__ void static_unit(int nM, int nN, int wgid0, Unit& u, int rot = 0) {
    const int nwg = nM * nN; int wgid = wgid0;
    { const int q = nwg / NXCD, r = nwg % NXCD, xcd = wgid % NXCD; int off = wgid / NXCD; const int qs = q + (xcd < r ? 1 : 0);
      if (rot) { off += rot; off -= (off >= qs) ? qs : 0; }
      wgid = (xcd < r ? xcd * (q + 1) : r * (q + 1) + (xcd - r) * q) + off; }
    const int nig = WGM * nN, gid = wgid / nig, fm = gid * WGM, gsz = (nM - fm) < WGM ? (nM - fm) : WGM;
    u.pm = fm + ((wgid % nig) % gsz); u.pn = (wgid % nig) / gsz; u.e = 0; u.rb = 0;
}
struct DenseOrder {
    static constexpr bool DENSE_A = true;
    int nM, nN, nwg, G, c, lda, K; const bf16_t* Bt;
    __device__ __forceinline__ bool next(int i, Unit& u) const { const long L = (long)i * G + c; if (L >= nwg) return false; static_unit(nM, nN, (int)L, u); u.ui = i; return true; }
    __device__ __forceinline__ void a_offsets(const Unit& u, int, unsigned (&off)[2][2]) const {
        const int tid = opaque_tid();
#pragma unroll
        for (int i = 0; i < 2; ++i) { int R, C; stage_rc(tid * 16 + i * 8192, R, C);
#pragma unroll
            for (int h = 0; h < 2; ++h) off[h][i] = (unsigned)((u.pm * BM + h * HALF + R) * lda + C) * 2u; }
    }
    __device__ __forceinline__ const char* b_tile(const Unit& u) const { return (const char*)(Bt + (size_t)u.pn * BM * K); }
};
constexpr int MOE_ROT = 16;
template <bool GATHER> struct MoeOrder {
    static constexpr bool DENSE_A = !GATHER;
    int nM, nN, nwg, G, c, lda, K; const bf16_t* Bt  ; size_t estride; LAS const int* tab; LAS const int* toks;
    int i0, ni, L; LAS const unsigned* lmask; unsigned* left;
    __device__ __forceinline__ bool next(int i, Unit& u) const {
        int id;
        if (GATHER) { if (i >= ni) return false; id = (i + i0) * G + c; if (id >= nwg) return false; static_unit(nM, nN, id, u); }
        else { const int v = (i + (c < L ? 2 : 0)) * G + c; const int mn = (v < G ? v : v - G) < L ? (v < G ? v : v - G) : L; const int resv = v < G ? mn : v < 2 * G ? L + mn : 2 * L;
               id = v - resv; if (id >= nwg) return false; static_unit(nM, nN, id, u, MOE_ROT); }
        u.ui = i;
        int e = 0;
#pragma unroll
        for (int q = 1; q < 16; ++q) e += (u.pm >= tab[16 + q]) ? 1 : 0;
        e = __builtin_amdgcn_readfirstlane(e); u.e = e; u.rb = __builtin_amdgcn_readfirstlane(u.pm - tab[16 + e]); return true;
    }
    __device__ __forceinline__ void a_offsets(const Unit& u, int ui, unsigned (&off)[2][2]) const {
        const int tid = opaque_tid();
        if (!GATHER) { if ((lmask[u.pm >> 5] >> (u.pm & 31)) & 1u) {
            unsigned sp = 0; while (xb_ld(left) < (unsigned)L && ++sp < XB_SPIN_CAP) __builtin_amdgcn_s_sleep(1);
            __builtin_amdgcn_fence(__ATOMIC_ACQUIRE, "agent"); } }
#pragma unroll
        for (int i = 0; i < 2; ++i) { int R, C; stage_rc(tid * 16 + i * 8192, R, C);
#pragma unroll
            for (int h = 0; h < 2; ++h) {
                if (GATHER) off[h][i] = (unsigned)(toks[ui * 256 + h * HALF + R] * lda + C) * 2u;
                else off[h][i] = (unsigned)((u.pm * BM + h * HALF + R) * lda + C) * 2u; } }
    }
    __device__ __forceinline__ const char* b_tile(const Unit& u) const { return (const char*)(Bt + (size_t)u.e * estride + (size_t)u.pn * BM * K); }
};

__device__ __forceinline__ unsigned cvt_pk_bf16(float lo, float hi) { unsigned r; asm volatile("v_cvt_pk_bf16_f32 %0, %1, %2" : "=v"(r) : "v"(lo), "v"(hi)); return r; }

struct EpiInProj {
    static constexpr bool PEEL = true; static constexpr bool FP8 = true; static constexpr bool PERM = true; static constexpr int NVM = 8;
    bf16_t* O; unsigned char* O8; LAS const float* bias_lds;
    __device__ __forceinline__ void operator()(f32x4 (&acc)[2][2][4][2], const Unit& u, int wr, int wc, int fr, int fq) const {
        const int row0 = u.pm * BM + wr * 64 + fr, cl = wc * 64 + 8 * fq, grp = u.pn >> 1, hc = (u.pn & 1) * BM + cl;
        LAS const float* bias = bias_lds + u.pn * BM;
#pragma unroll
        for (int bj = 0; bj < 2; ++bj)
#pragma unroll
            for (int n = 0; n < 2; ++n) { const f32x4 bv = *(LAS const f32x4*)(bias + cl + bj * 32 + 4 * n);
#pragma unroll
                for (int ai = 0; ai < 2; ++ai)
#pragma unroll
                    for (int m = 0; m < 4; ++m) acc[ai][bj][m][n] = acc[ai][bj][m][n] * (1.0f / WIN_SCALE) + bv; }
        if (grp >= 5) {
            const int c8 = CU + (u.pn - 10) * HALF + wc * 32 + 8 * fq;
#pragma unroll
            for (int ai = 0; ai < 2; ++ai)
#pragma unroll
                for (int m = 0; m < 4; ++m) { u32x2 a; a.x = pack4_fp8c(acc[ai][0][m][0] * acc[ai][1][m][0], 1.0f); a.y = pack4_fp8c(acc[ai][0][m][1] * acc[ai][1][m][1], 1.0f);
                    *(u32x2*)(O8 + (size_t)(row0 + ai * HALF + m * 16) * NCV + c8) = a; }
        } else {
            const int c8 = (grp == 0 ? CQ : grp == 1 ? CGB : grp == 2 ? CK : grp == 3 ? CVV : CO) + hc;
#pragma unroll
            for (int ai = 0; ai < 2; ++ai)
#pragma unroll
                for (int m = 0; m < 4; ++m) { unsigned char* rowp = O8 + (size_t)(row0 + ai * HALF + m * 16) * NCV + (c8 - 8 * fq) + (fq & 1) * 32 + 8 * (fq & ~1);
                    u32x2 a, b; a.x = pack4_fp8c(acc[ai][0][m][0], 1.0f); a.y = pack4_fp8c(acc[ai][0][m][1], 1.0f); b.x = pack4_fp8c(acc[ai][1][m][0], 1.0f); b.y = pack4_fp8c(acc[ai][1][m][1], 1.0f);
                    *(u32x4*)rowp = widen_fp8_pair(a, b); }
        }
    }
};
struct EpiOutProj {
    static constexpr bool PEEL = true; static constexpr bool FP8 = true; static constexpr bool PERM = true; static constexpr int NVM = 16;
    bf16_t* O; const bf16_t* X;
    __device__ __forceinline__ void operator()(const f32x4 (&acc)[2][2][4][2], const Unit& u, int wr, int wc, int fr, int fq) const {
        const int row0 = u.pm * BM + wr * 64 + fr, col0 = u.pn * BM + wc * 64 + 8 * fq;
        constexpr float IS = 1.0f / (Y_SCALE * WOUT_SCALE);
        u32x4 xr[2][4][2];
#pragma unroll
        for (int ai = 0; ai < 2; ++ai)
#pragma unroll
            for (int m = 0; m < 4; ++m)
#pragma unroll
                for (int bj = 0; bj < 2; ++bj) xr[ai][m][bj] = *(const u32x4*)(X + (size_t)(row0 + ai * HALF + m * 16) * D + col0 + bj * 32);
#pragma unroll
        for (int ai = 0; ai < 2; ++ai)
#pragma unroll
            for (int m = 0; m < 4; ++m)
#pragma unroll
                for (int bj = 0; bj < 2; ++bj) asm volatile("" : "+v"(xr[ai][m][bj]));
#pragma unroll
        for (int ai = 0; ai < 2; ++ai)
#pragma unroll
            for (int m = 0; m < 4; ++m) { const size_t off = (size_t)(row0 + ai * HALF + m * 16) * D + col0;
#pragma unroll
                for (int bj = 0; bj < 2; ++bj) { float xf[8]; unpack8(xr[ai][m][bj], xf);
                    const f32x4 a0 = acc[ai][bj][m][0], a1 = acc[ai][bj][m][1];
                    u32x4 w; w.x = cvt_pk_bf16(a0[0] * IS + ALPHA * xf[0], a0[1] * IS + ALPHA * xf[1]); w.y = cvt_pk_bf16(a0[2] * IS + ALPHA * xf[2], a0[3] * IS + ALPHA * xf[3]);
                    w.z = cvt_pk_bf16(a1[0] * IS + ALPHA * xf[4], a1[1] * IS + ALPHA * xf[5]); w.w = cvt_pk_bf16(a1[2] * IS + ALPHA * xf[6], a1[3] * IS + ALPHA * xf[7]);
                    *(u32x4*)(O + off + bj * 32) = w; } }
    }
};
struct EpiGateUp {
    static constexpr bool PEEL = true; static constexpr bool FP8 = true; static constexpr bool PERM = true; static constexpr int NVM = 8;
    unsigned char* O;
    __device__ __forceinline__ void operator()(const f32x4 (&acc)[2][2][4][2], const Unit& u, int wr, int wc, int fr, int fq) const {
        const int row0 = u.pm * BM + wr * 64 + fr, col0 = u.pn * HALF + wc * 32 + 8 * fq;
        constexpr float TS = -1.4426950408889634f / WGU_SCALE, HS = H_SCALE / (WGU_SCALE * WGU_SCALE);
#pragma unroll
        for (int ai = 0; ai < 2; ++ai)
#pragma unroll
            for (int m = 0; m < 4; ++m) { u32x2 hw;
#pragma unroll
                for (int n = 0; n < 2; ++n) { const f32x4 g = acc[ai][0][m][n], up = acc[ai][1][m][n];
                    const f32x4 t4 = g * TS; const f32x4 e4 = (f32x4){__builtin_amdgcn_exp2f(t4[0]), __builtin_amdgcn_exp2f(t4[1]), __builtin_amdgcn_exp2f(t4[2]), __builtin_amdgcn_exp2f(t4[3])} + 1.0f;
                    const f32x4 r4 = (f32x4){__builtin_amdgcn_rcpf(e4[0]), __builtin_amdgcn_rcpf(e4[1]), __builtin_amdgcn_rcpf(e4[2]), __builtin_amdgcn_rcpf(e4[3])};
                    const unsigned pw = pack4_fp8c((g * up) * r4, HS); if (n == 0) hw.x = pw; else hw.y = pw; }
                *(u32x2*)(O + (size_t)(row0 + ai * HALF + m * 16) * DFF + col0) = hw; }
    }
};
struct EpiDown {
    static constexpr bool PEEL = false; static constexpr bool FP8 = true; static constexpr bool PERM = true; static constexpr int NVM = 8;
    unsigned char* O; LAS const float* gates; LAS const int* dsts;
    __device__ __forceinline__ void operator()(const f32x4 (&acc)[2][2][4][2], const Unit& u, int wr, int wc, int fr, int fq) const {
        const int rl0 = wr * 64 + fr, col0 = u.pn * BM + wc * 64 + 8 * fq;
#pragma unroll
        for (int ai = 0; ai < 2; ++ai)
#pragma unroll
            for (int m = 0; m < 4; ++m) { const int rl = rl0 + ai * HALF + m * 16;
                const float g = gates[u.ui * 256 + rl] * (YB_SCALE / (H_SCALE * WDN_SCALE)); const int d = dsts[u.ui * 256 + rl];
                u32x2 a, b; a.x = pack4_fp8c(acc[ai][0][m][0], g); a.y = pack4_fp8c(acc[ai][0][m][1], g); b.x = pack4_fp8c(acc[ai][1][m][0], g); b.y = pack4_fp8c(acc[ai][1][m][1], g);
                const u32x4 w = widen_fp8_pair(a, b);
                unsigned char* rowp = O + (unsigned)((d < 0 ? 2 * M : (d & 1) * M + (d >> 1)) * D + (col0 - 8 * fq) + (fq & 1) * 32 + 8 * (fq & ~1));
                *(u32x4*)rowp = w; }
    }
};

template <class Epi, class Sched, bool ALIGN = true>
__device__ __forceinline__ void gemm_phase(LAS unsigned char* lds, const bf16_t* Aptr, const Sched& S, const Epi& E) {
    const int tid = opaque_tid(), wid = __builtin_amdgcn_readfirstlane(tid >> 6), lane = tid & 63, wr = wid >> 2, wc = wid & 3, fr = lane & 15, fq = lane >> 4;
    const int K = S.K, nt = K / BK;
    unsigned voffB[2];
#pragma unroll
    for (int i = 0; i < 2; ++i) { int R, C; stage_rc(tid * 16 + i * 8192, R, C); const int Rb = 64 * (R >> 5) + perm32(R & 31); voffB[i] = (unsigned)(Rb * K + C) * 2u; }
    const size_t kstep = (size_t)(BK * 2);
    const size_t hstep = (size_t)32 * K * 2;
    const unsigned ldsw = (unsigned)wid * 1024u;
    const int aoff = lds_byte(wr * 64 + fr, fq * 8), boff = lds_byte(wc * 32 + fr, fq * 8);
    const int aoff8 = lds_byte(wr * 64 + fr, (fq & 1) * 16) + (fq >> 1) * 1024, boff8 = lds_byte(wc * 32 + fr, (fq & 1) * 16) + (fq >> 1) * 1024;
    const char* Abase = (const char*)Aptr; const size_t ahalf = (size_t)HALF * S.lda * 2;
#define PG8_SA(b, h) (((b) * 2 + (h)) * HTB)
#define PG8_SB(b, h) ((4 + (b) * 2 + (h)) * HTB)
#define PG8_STAGE(bufoff, gbase, voff) do { _Pragma("unroll") for (int _i = 0; _i < 2; ++_i) \
        __builtin_amdgcn_global_load_lds((const unsigned*)((const char*)(gbase) + (voff)[_i]), (LAS unsigned*)(lds + (bufoff) + ldsw + _i * 8192), 16, 0, 0); } while (0)
#define PG8_STAGEA(bufoff, kb, off) PG8_STAGE(bufoff, Abase + (kb), off)
#define PG8_STAGEA1(bufoff, kb) do { if (Sched::DENSE_A) PG8_STAGE(bufoff, Abase + (kb) + ahalf, offC[0]); else PG8_STAGE(bufoff, Abase + (kb), offC[1]); } while (0)
typedef int i32x4v_ __attribute__((ext_vector_type(4)));
#define PG8_CAT8(x0_, x1_) __builtin_shufflevector(__builtin_bit_cast(i32x4v_, x0_), __builtin_bit_cast(i32x4v_, x1_), 0, 1, 2, 3, 4, 5, 6, 7)
#define PG8_LDA(dst, b, h) do { if (Epi::FP8) { _Pragma("unroll") for (int m = 0; m < 4; ++m) dst##8[m] = PG8_CAT8(*(const LAS bf16x8*)(lds + PG8_SA(b, h) + aoff + m * 2048), *(const LAS bf16x8*)(lds + PG8_SA(b, h) + aoff + m * 2048 + 1024)); } \
        else { _Pragma("unroll") for (int m = 0; m < 4; ++m) _Pragma("unroll") for (int k = 0; k < 2; ++k) dst[m][k] = *(const LAS bf16x8*)(lds + PG8_SA(b, h) + aoff + m * 2048 + k * 1024); } } while (0)
#define PG8_LDB(dst, b, h) do { if (Epi::FP8) { _Pragma("unroll") for (int n = 0; n < 2; ++n) dst##8[n] = PG8_CAT8(*(const LAS bf16x8*)(lds + PG8_SB(b, h) + boff + n * 2048), *(const LAS bf16x8*)(lds + PG8_SB(b, h) + boff + n * 2048 + 1024)); } \
        else { _Pragma("unroll") for (int n = 0; n < 2; ++n) _Pragma("unroll") for (int k = 0; k < 2; ++k) dst[n][k] = *(const LAS bf16x8*)(lds + PG8_SB(b, h) + boff + n * 2048 + k * 1024); } } while (0)
#define PG8_MMA(ai, bj, At, Bt) do { __builtin_amdgcn_s_setprio(1); \
        if (Epi::FP8) { _Pragma("unroll") for (int m = 0; m < 4; ++m) _Pragma("unroll") for (int n = 0; n < 2; ++n) \
                acc[ai][bj][m][n] = __builtin_amdgcn_mfma_scale_f32_16x16x128_f8f6f4(Bt##8[n], At##8[m], acc[ai][bj][m][n], 0, 0, 0, 0x7f7f7f7f, 0, 0x7f7f7f7f); \
              \
            _Pragma("unroll") for (int m = 0; m < 4; ++m) _Pragma("unroll") for (int n = 0; n < 2; ++n) asm volatile("" : "+v"(acc[ai][bj][m][n])); \
        } else { _Pragma("unroll") for (int m = 0; m < 4; ++m) _Pragma("unroll") for (int n = 0; n < 2; ++n) _Pragma("unroll") for (int k = 0; k < 2; ++k) \
            acc[ai][bj][m][n] = __builtin_amdgcn_mfma_f32_16x16x32_bf16(Bt[n][k], At[m][k], acc[ai][bj][m][n], 0, 0, 0); } \
        __builtin_amdgcn_s_setprio(0); } while (0)
#define PG8_WAIT_V(n) asm volatile("s_waitcnt vmcnt(" #n ")" ::: "memory")
#define PG8_WAIT_VN(a) asm volatile("s_waitcnt vmcnt(%0)" :: "n"(a) : "memory")
#define PG8_WAIT_L(n) asm volatile("s_waitcnt lgkmcnt(" #n ")" ::: "memory")
#define PG8_BAR __builtin_amdgcn_s_barrier()
#define PG8_SCHED __builtin_amdgcn_sched_barrier(0)
    Unit cur, nxt; int ui = 0;
    if (!S.next(0, cur)) return;
    f32x4 acc[2][2][4][2];
#pragma unroll
    for (int a = 0; a < 2; ++a)
#pragma unroll
        for (int b = 0; b < 2; ++b)
#pragma unroll
            for (int m = 0; m < 4; ++m)
#pragma unroll
                for (int n = 0; n < 2; ++n) acc[a][b][m][n] = (f32x4){0.f, 0.f, 0.f, 0.f};
    bf16x8 At[4][2], B0[2][2], B1[2][2]; i32x8v At8[4], B08[2], B18[2];
    unsigned offC[2][2];
    S.a_offsets(cur, 0, offC);
    const char* cB = S.b_tile(cur);
    PG8_STAGE(PG8_SB(0, 0), cB, voffB); PG8_STAGE(PG8_SB(0, 1), cB + hstep, voffB); PG8_STAGEA(PG8_SA(0, 0), 0, offC[0]); PG8_STAGEA1(PG8_SA(0, 1), 0);
    if (wr == 1) PG8_BAR;
    PG8_WAIT_V(2); PG8_BAR;
    PG8_STAGE(PG8_SB(1, 0), cB + kstep, voffB); PG8_STAGEA(PG8_SA(1, 0), kstep, offC[0]); PG8_STAGE(PG8_SB(1, 1), cB + hstep + kstep, voffB);
    PG8_WAIT_V(0); PG8_BAR;
    for (;;) {
        const bool has_next = S.next(ui + 1, nxt);
        const char* nB = has_next ? S.b_tile(nxt) : cB;
#define PG8_PAIR(t_, last_, WA, WC) do { const int t = (t_); const bool last = (last_); \
            const size_t k1 = (size_t)(t + 1) * kstep; \
            const size_t k2 = last ? 0 : (size_t)(t + 2) * kstep, k3 = k2 + kstep; \
            const char* b2 = last ? nB : cB + (size_t)(t + 2) * kstep; const char* b3 = b2 + kstep; \
              \
            PG8_LDB(B0, 0, 0); PG8_LDB(B1, 0, 1); PG8_SCHED; PG8_LDA(At, 0, 0); PG8_STAGEA1(PG8_SA(1, 1), k1); \
            PG8_WAIT_VN(WA); PG8_WAIT_L(0); PG8_BAR; PG8_MMA(0, 0, At, B0); PG8_MMA(0, 1, At, B1); PG8_BAR; PG8_SCHED; \
            if (last && has_next) S.a_offsets(nxt, ui + 1, offC);        \
              \
            PG8_LDA(At, 0, 1); PG8_STAGE(PG8_SB(0, 0), b2, voffB); PG8_STAGE(PG8_SB(0, 1), b2 + hstep, voffB); PG8_STAGEA(PG8_SA(0, 0), k2, offC[0]); \
            PG8_WAIT_VN(WA); PG8_WAIT_L(0); PG8_BAR; PG8_MMA(1, 0, At, B0); PG8_MMA(1, 1, At, B1); PG8_BAR; PG8_SCHED; \
              \
            PG8_LDB(B0, 1, 0); PG8_LDB(B1, 1, 1); PG8_SCHED; PG8_LDA(At, 1, 0); PG8_STAGEA1(PG8_SA(0, 1), k2); \
            PG8_WAIT_VN(WC); PG8_WAIT_L(0); PG8_BAR; PG8_MMA(0, 0, At, B0); PG8_MMA(0, 1, At, B1); PG8_BAR; PG8_SCHED; \
              \
            PG8_LDA(At, 1, 1); PG8_STAGE(PG8_SB(1, 0), b3, voffB); PG8_STAGE(PG8_SB(1, 1), b3 + hstep, voffB); PG8_STAGEA(PG8_SA(1, 0), k3, offC[0]); \
            PG8_WAIT_VN(WC); PG8_WAIT_L(0); PG8_BAR; PG8_MMA(1, 0, At, B0); PG8_MMA(1, 1, At, B1); PG8_BAR; PG8_SCHED; } while (0)
        if (Epi::PEEL) { PG8_PAIR(0, false, 8 + Epi::NVM, 8);
            for (int tt = 2; tt < nt; tt += 2) PG8_PAIR(tt, tt == nt - 2, 8, 8); }
        else { for (int tt = 0; tt < nt; tt += 2) PG8_PAIR(tt, tt == nt - 2, 8, 8); }
#undef PG8_PAIR
        if (ALIGN || !has_next) { if (wr == 0) PG8_BAR; }
        MFMA_DRAIN();
        { const int l2 = opaque_tid() & 63; E(acc, cur, wr, wc, l2 & 15, l2 >> 4); }
        PG8_SCHED;
        if (!has_next) break;
#pragma unroll
        for (int a = 0; a < 2; ++a)
#pragma unroll
            for (int b = 0; b < 2; ++b)
#pragma unroll
                for (int m = 0; m < 4; ++m)
#pragma unroll
                    for (int n = 0; n < 2; ++n) acc[a][b][m][n] = (f32x4){0.f, 0.f, 0.f, 0.f};
        cur = nxt; cB = nB; ++ui;
        if (ALIGN) { if (wr == 1) PG8_BAR; }
    }
    PG8_WAIT_V(0);
    PG8_BAR;
#undef PG8_SA
#undef PG8_SB
#undef PG8_STAGE
#undef PG8_STAGEA
#undef PG8_LDA
#undef PG8_LDB
#undef PG8_MMA
#undef PG8_WAIT_V
#undef PG8_WAIT_L
#undef PG8_BAR
#undef PG8_SCHED
}
}

struct Args { const float* in[15]; float* out; unsigned char* ws; int ph_lo, ph_hi, li, pad; };
struct Ctx {
    LAS unsigned char* lds; int tid, lane, wave, G, wg;
    const float *x, *w_in, *b_in, *conv_w, *mh_g, *w_out, *ln_mix_g, *ln_mix_b, *router_w, *router_b, *w_gate, *w_up, *w_down, *ln_moe_g, *ln_moe_b;
    float* out; unsigned char* ws;
};

__device__ __forceinline__ void load_row_bf16(const bf16_t* row, int lane, float (&v)[16]) {
    const u32x4 a = *(const u32x4*)(row + 8 * lane), b = *(const u32x4*)(row + 512 + 8 * lane);
    float t[8]; unpack8(a, t);
#pragma unroll
    for (int i = 0; i < 8; ++i) v[i] = t[i];
    unpack8(b, t);
#pragma unroll
    for (int i = 0; i < 8; ++i) v[8 + i] = t[i];
}
__device__ __forceinline__ void load_row_f32(const float* row, int lane, float (&v)[16]) {
#pragma unroll
    for (int j = 0; j < 2; ++j)
#pragma unroll
        for (int q = 0; q < 2; ++q) { const f32x4 a = *(const f32x4*)(row + 512 * j + 8 * lane + 4 * q);
            v[8 * j + 4 * q + 0] = a[0]; v[8 * j + 4 * q + 1] = a[1]; v[8 * j + 4 * q + 2] = a[2]; v[8 * j + 4 * q + 3] = a[3]; }
}
__device__ __forceinline__ void store_row_bf16(bf16_t* row, int lane, const float (&v)[16]) {
    u32x4 a, b; a.x = pk2(v[0], v[1]); a.y = pk2(v[2], v[3]); a.z = pk2(v[4], v[5]); a.w = pk2(v[6], v[7]);
    b.x = pk2(v[8], v[9]); b.y = pk2(v[10], v[11]); b.z = pk2(v[12], v[13]); b.w = pk2(v[14], v[15]);
    *(u32x4*)(row + 8 * lane) = a; *(u32x4*)(row + 512 + 8 * lane) = b;
}
__device__ __forceinline__ void store_row_f32(float* row, int lane, const float (&v)[16]) {
#pragma unroll
    for (int j = 0; j < 2; ++j)
#pragma unroll
        for (int q = 0; q < 2; ++q) *(f32x4*)(row + 512 * j + 8 * lane + 4 * q) = (f32x4){v[8 * j + 4 * q], v[8 * j + 4 * q + 1], v[8 * j + 4 * q + 2], v[8 * j + 4 * q + 3]};
}
__device__ __forceinline__ void ln_inplace(float (&v)[16], const float (&g)[16], const float (&b)[16], int lane) {
    float s = 0.f;
#pragma unroll
    for (int i = 0; i < 16; ++i) s += v[i];
    const float mean = wave_sum(s, lane) * (1.0f / D); float q = 0.f;
#pragma unroll
    for (int i = 0; i < 16; ++i) { v[i] -= mean; q += v[i] * v[i]; }
    const float rstd = __builtin_amdgcn_rsqf(wave_sum(q, lane) * (1.0f / D) + LN_EPS);
#pragma unroll
    for (int i = 0; i < 16; ++i) v[i] = v[i] * rstd * g[i] + b[i];
}
__device__ __forceinline__ int wperm_idx(int j, int k) { const int h = k >> 9, ln = (k & 511) >> 3, half = (k >> 2) & 1, i = k & 3; return ((j * 2 + h) * 2 + half) * 256 + ln * 4 + i; }
__device__ __forceinline__ void fill_wif(const Ctx& F, int l, LAS float* wif) {
    for (int k = F.tid; k < D; k += NTHR) { const float* src = F.w_in + ((size_t)l * D + k) * PIN + SRC_IF; const f32x4 a = *(const f32x4*)src, b = *(const f32x4*)(src + 4);
        wif[wperm_idx(0, k)] = a[0]; wif[wperm_idx(1, k)] = a[1]; wif[wperm_idx(2, k)] = a[2]; wif[wperm_idx(3, k)] = a[3];
        wif[wperm_idx(4, k)] = b[0]; wif[wperm_idx(5, k)] = b[1]; wif[wperm_idx(6, k)] = b[2]; wif[wperm_idx(7, k)] = b[3]; }
}
template <int NR, int NJ> __device__ __forceinline__ void row_dots(const float (&v)[NR][16], LAS const float* tab, int lane, float (&out)[NR * NJ]) {
#pragma unroll
    for (int j = 0; j < NJ; ++j) {
        float s[NR];
#pragma unroll
        for (int rr = 0; rr < NR; ++rr) s[rr] = 0.f;
#pragma unroll
        for (int hh = 0; hh < 4; ++hh) { const f32x4 w = *(LAS const f32x4*)(tab + (j * 4 + hh) * 256 + lane * 4);
#pragma unroll
            for (int rr = 0; rr < NR; ++rr) s[rr] += v[rr][4 * hh] * w[0] + v[rr][4 * hh + 1] * w[1] + v[rr][4 * hh + 2] * w[2] + v[rr][4 * hh + 3] * w[3]; }
#pragma unroll
        for (int rr = 0; rr < NR; ++rr) out[rr * NJ + j] = s[rr]; }
}
__device__ __forceinline__ int idx16(int lane) { return ((lane >> 5) & 1) * 8 + ((lane >> 4) & 1) * 4 + ((lane >> 3) & 1) * 2 + ((lane >> 2) & 1); }
__device__ __forceinline__ float reduce16(const float (&x)[16], int lane) {
    const bool b3 = (lane & 8) != 0, b2 = (lane & 4) != 0;
    float y[8], z[4], u[2];
#pragma unroll
    for (int i = 0; i < 8; ++i) { const auto r = __builtin_amdgcn_permlane32_swap(__float_as_uint(x[i]), __float_as_uint(x[8 + i]), false, false); y[i] = __uint_as_float(r[0]) + __uint_as_float(r[1]); }
#pragma unroll
    for (int i = 0; i < 4; ++i) { const auto r = __builtin_amdgcn_permlane16_swap(__float_as_uint(y[i]), __float_as_uint(y[4 + i]), false, false); z[i] = __uint_as_float(r[0]) + __uint_as_float(r[1]); }
#pragma unroll
    for (int i = 0; i < 2; ++i) { const float keep = b3 ? z[2 + i] : z[i], send = b3 ? z[i] : z[2 + i]; u[i] = keep + dpp_mov<0x128>(send); }
    const float keep = b2 ? u[1] : u[0], send = b2 ? u[0] : u[1]; float t = keep + dpp_mov<0x141>(send);
    t += dpp_mov<0x4E>(t); t += dpp_mov<0xB1>(t);
    return t;
}
__device__ __forceinline__ void ln_inplace_lds(float (&v)[16], LAS const float* gb, int lane) {
    float s = 0.f;
#pragma unroll
    for (int i = 0; i < 16; ++i) s += v[i];
    const float mean = wave_sum(s, lane) * (1.0f / D); float q = 0.f;
#pragma unroll
    for (int i = 0; i < 16; ++i) { v[i] -= mean; q += v[i] * v[i]; }
    const float rstd = __builtin_amdgcn_rsqf(wave_sum(q, lane) * (1.0f / D) + LN_EPS);
#pragma unroll
    for (int hh = 0; hh < 4; ++hh) { const f32x4 g4 = *(LAS const f32x4*)(gb + hh * 256 + lane * 4), b4 = *(LAS const f32x4*)(gb + (4 + hh) * 256 + lane * 4);
#pragma unroll
        for (int i = 0; i < 4; ++i) v[4 * hh + i] = v[4 * hh + i] * rstd * g4[i] + b4[i]; }
}
__device__ __forceinline__ void unpack_row(const u32x4 a, const u32x4 b, float (&v)[16]) {
    float t[8]; unpack8(a, t);
#pragma unroll
    for (int i = 0; i < 8; ++i) v[i] = t[i];
    unpack8(b, t);
#pragma unroll
    for (int i = 0; i < 8; ++i) v[8 + i] = t[i];
}

__device__ __forceinline__ void transpose_item(const float* src, int lds_, bf16_t* dst, int ldd, LAS float* scr, int lane) {
#pragma unroll 8
    for (int i = 0; i < 32; ++i) { const int kk = 2 * i + (lane >> 5); scr[kk * 33 + (lane & 31)] = src[(size_t)kk * lds_ + (lane & 31)]; }
    LDS_WAIT(); asm volatile("" ::: "memory");
    const int c = lane & 7;
#pragma unroll
    for (int j = 0; j < 4; ++j) { const int n = (lane >> 3) + 8 * j; const LAS float* s = scr + (8 * c) * 33 + n;
        u32x4 o; o.x = pk2(s[0 * 33], s[1 * 33]); o.y = pk2(s[2 * 33], s[3 * 33]); o.z = pk2(s[4 * 33], s[5 * 33]); o.w = pk2(s[6 * 33], s[7 * 33]);
        *(u32x4*)(dst + (size_t)n * ldd + 8 * c) = o; }
    LDS_WAIT(); asm volatile("" ::: "memory");
}
__device__ __forceinline__ void transpose_item_fp8(const float* src, int lds_, unsigned char* dst8, int ldd8, float scale, LAS float* scr, int lane) {
#pragma unroll 8
    for (int i = 0; i < 32; ++i) { const int kk = 2 * i + (lane >> 5); scr[kk * 33 + (lane & 31)] = src[(size_t)kk * lds_ + (lane & 31)]; }
    LDS_WAIT(); asm volatile("" ::: "memory");
    const int c = lane & 7;
#pragma unroll
    for (int j = 0; j < 4; ++j) { const int n = (lane >> 3) + 8 * j; const LAS float* s = scr + (8 * c) * 33 + n;
        u32x2 o; o.x = pack4_fp8c((f32x4){s[0 * 33], s[1 * 33], s[2 * 33], s[3 * 33]}, scale); o.y = pack4_fp8c((f32x4){s[4 * 33], s[5 * 33], s[6 * 33], s[7 * 33]}, scale);
        *(u32x2*)(dst8 + (size_t)n * ldd8 + 8 * c) = o; }
    LDS_WAIT(); asm volatile("" ::: "memory");
}
__device__ __forceinline__ void p0_prologue(const Ctx& F) {
    LAS float* scr = (LAS float*)(F.lds + 32768 + F.wave * 8704);
    const int gw = F.wg * NWAVES + F.wave, NGW = F.G * NWAVES;
    constexpr int I_IN = 16 * 112, I_OUT = 16 * 32, I_GU = 16 * 16 * 32, I_DN = 16 * 8 * 32, I_L = I_IN + I_OUT + I_GU + I_DN;
    bf16_t* WIN = (bf16_t*)(F.ws + WS_WIN); bf16_t* WOUT = (bf16_t*)(F.ws + WS_WOUT); bf16_t* WGU = (bf16_t*)(F.ws + WS_WGU); bf16_t* WDN = (bf16_t*)(F.ws + WS_WDN);
    for (int it = gw; it < DEPTH * I_L; it += NGW) {
        const int l = it / I_L; int r = it % I_L;
        if (r < I_IN) { const int kb = r / 112, nb = r % 112, n0 = 32 * nb, grp = n0 >> 9;
            const int src0 = win_src_col(n0); (void)grp;
            transpose_item_fp8(F.w_in + ((size_t)l * D + 64 * kb) * PIN + src0, PIN, (unsigned char*)WIN + ((size_t)l * NP + n0) * D + 64 * kb, D, WIN_SCALE, scr, F.lane); continue; }
        r -= I_IN;
        if (r < I_OUT) { const int kb = r / 32, nb = r % 32;
            transpose_item_fp8(F.w_out + ((size_t)l * D + 64 * kb) * D + 32 * nb, D, (unsigned char*)WOUT + ((size_t)l * D + 32 * nb) * D + 64 * kb, D, WOUT_SCALE, scr, F.lane); continue; }
        r -= I_OUT;
        if (r < I_GU) { const int e = r / 512, q = r % 512, kb = q / 32, nb = q % 32, n0 = 32 * nb;
            const int pn = n0 >> 8, w = n0 & 255; const float* srcm = ((w >> 5) & 1) ? F.w_up : F.w_gate; const int scol = pn * 128 + 32 * (w >> 6);
            transpose_item_fp8(srcm + (((size_t)l * NE + e) * D + 64 * kb) * DFF + scol, DFF, (unsigned char*)WGU + (((size_t)l * NE + e) * 1024 + n0) * D + 64 * kb, D, WGU_SCALE, scr, F.lane); continue; }
        r -= I_GU;
        { const int e = r / 256, q = r % 256, kb = q / 32, nb = q % 32;
            transpose_item_fp8(F.w_down + (((size_t)l * NE + e) * DFF + 64 * kb) * D + 32 * nb, D, (unsigned char*)WDN + (((size_t)l * NE + e) * D + 32 * nb) * DFF + 64 * kb, DFF, WDN_SCALE, scr, F.lane); }
    }
    { u32x4* RFB = (u32x4*)(F.ws + WS_RFB);
      for (int idx = F.wg * NTHR + F.tid; idx < 32 * 64; idx += F.G * NTHR) { const int kk = idx >> 6, ln = idx & 63, rr = ln & 15, qq = ln >> 4; float w[8], wl[8];
#pragma unroll
          for (int i = 0; i < 8; ++i) w[i] = F.router_w[(size_t)(32 * kk + 8 * qq + i) * 16 + rr];
          const u32x4 hi = pack8(w); float hf[8]; unpack8(hi, hf);
#pragma unroll
          for (int i = 0; i < 8; ++i) wl[i] = w[i] - hf[i];
          RFB[(kk * 2) * 64 + ln] = hi; RFB[(kk * 2 + 1) * 64 + ln] = pack8(wl); }
      float* WIFP = (float*)(F.ws + WS_WIFP);
      for (int idx = F.wg * NTHR + F.tid; idx < DEPTH * D; idx += F.G * NTHR) { const int ll = idx >> 10, k = idx & 1023; const float* src = F.w_in + ((size_t)ll * D + k) * PIN + SRC_IF; const f32x4 a = *(const f32x4*)src, b = *(const f32x4*)(src + 4);
          float* dst = WIFP + (size_t)ll * 8 * D;
          dst[wperm_idx(0, k)] = a[0]; dst[wperm_idx(1, k)] = a[1]; dst[wperm_idx(2, k)] = a[2]; dst[wperm_idx(3, k)] = a[3]; dst[wperm_idx(4, k)] = b[0]; dst[wperm_idx(5, k)] = b[1]; dst[wperm_idx(6, k)] = b[2]; dst[wperm_idx(7, k)] = b[3]; } }
    LAS float* wif = (LAS float*)F.lds;
    fill_wif(F, 0, wif);
    __syncthreads();
    bf16_t* X = (bf16_t*)(F.ws + WS_X); float* GATES = (float*)(F.ws + WS_GATES);
    const int npair = M / (2 * NGW);
    f32x4 raw[2][4];
#pragma unroll
    for (int rr = 0; rr < 2; ++rr) { const float* row = F.x + (size_t)(gw + NGW * rr) * D;
#pragma unroll
        for (int jq = 0; jq < 4; ++jq) raw[rr][jq] = *(const f32x4*)(row + 512 * (jq >> 1) + 8 * F.lane + 4 * (jq & 1)); }
    for (int it = 0; it < npair; ++it) {
        float v[2][16];
#pragma unroll
        for (int rr = 0; rr < 2; ++rr)
#pragma unroll
            for (int jq = 0; jq < 4; ++jq) { v[rr][4 * jq] = raw[rr][jq][0]; v[rr][4 * jq + 1] = raw[rr][jq][1]; v[rr][4 * jq + 2] = raw[rr][jq][2]; v[rr][4 * jq + 3] = raw[rr][jq][3]; }
        if (it + 1 < npair) {
#pragma unroll
            for (int rr = 0; rr < 2; ++rr) { const float* row = F.x + (size_t)(gw + NGW * (2 * it + 2 + rr)) * D;
#pragma unroll
                for (int jq = 0; jq < 4; ++jq) raw[rr][jq] = *(const f32x4*)(row + 512 * (jq >> 1) + 8 * F.lane + 4 * (jq & 1)); } }
        float part[16]; row_dots<2, 8>(v, wif, F.lane, part);
        const float tot = reduce16(part, F.lane);
#pragma unroll
        for (int rr = 0; rr < 2; ++rr) store_row_bf16(X + (size_t)(gw + NGW * (2 * it + rr)) * D, F.lane, v[rr]);
#pragma unroll
        for (int rr = 0; rr < 2; ++rr)
#pragma unroll
            for (int j = 0; j < 2; ++j) { u32x2 f8; f8.x = pack4_fp8c((f32x4){v[rr][8 * j], v[rr][8 * j + 1], v[rr][8 * j + 2], v[rr][8 * j + 3]}, 1.0f); f8.y = pack4_fp8c((f32x4){v[rr][8 * j + 4], v[rr][8 * j + 5], v[rr][8 * j + 6], v[rr][8 * j + 7]}, 1.0f);
                *(u32x2*)(F.ws + WS_XF + (size_t)(gw + NGW * (2 * it + rr)) * D + 512 * j + 8 * F.lane) = f8; }
        if ((F.lane & 3) == 0) { const int ix = idx16(F.lane), rr = ix >> 3, j = ix & 7; GATES[(size_t)(gw + NGW * (2 * it + rr)) * 8 + j] = tot + F.b_in[SRC_IF + j]; }
    }
}

typedef short s16x4 __attribute__((ext_vector_type(4)));
__device__ __forceinline__ void tr_issue(s16x4& d, unsigned addr) { asm volatile("ds_read_b64_tr_b16 %0, %1" : "=&v"(d) : "v"(addr) : "memory"); }
#define TR_ISSUE_OFF(d, addr, off) asm volatile("ds_read_b64_tr_b16 %0, %1 offset:%2" : "=&v"(d) : "v"(addr), "i"(off) : "memory")
#define TR_WAIT4(a, b, c, d) asm volatile("s_waitcnt lgkmcnt(0)" : "+v"(a), "+v"(b), "+v"(c), "+v"(d) :: "memory")
#define TR_WAIT2(a, b) asm volatile("s_waitcnt lgkmcnt(0)" : "+v"(a), "+v"(b) :: "memory")
#define TR_WAIT8(a, b, c, d, e, f, g, h) asm volatile("s_waitcnt lgkmcnt(0)" : "+v"(a), "+v"(b), "+v"(c), "+v"(d), "+v"(e), "+v"(f), "+v"(g), "+v"(h) :: "memory")
__device__ __forceinline__ bf16x8 cat8(s16x4 lo, s16x4 hi) { return __builtin_shufflevector(lo, hi, 0, 1, 2, 3, 4, 5, 6, 7); }

__device__ __forceinline__ float wave_incl_scan_add(float x, int lane) {
#pragma unroll
    for (int o = 1; o < 64; o <<= 1) { const float t = shup(x, o, lane); if (lane >= o) x += t; }
    return x;
}
__device__ __forceinline__ float wave_incl_scan_max(float x, int lane) {
#pragma unroll
    for (int o = 1; o < 64; o <<= 1) { const float t = shup(x, o, lane); if (lane >= o) x = fmaxf(x, t); }
    return x;
}
__device__ __forceinline__ float log_sigmoid(float f) { return fminf(f, 0.f) - log1pf(expf(-fabsf(f))); }
__device__ __forceinline__ int off_tr2(int row, int ch) { return row * 256 + ((ch ^ (2 * ((row & 3) | ((row >> 1) & 4)))) << 4); }

__device__ __forceinline__ void p2_local_conv(const Ctx& F, int l) {
    const float* GATES = (const float*)(F.ws + WS_GATES);
    unsigned char* CS = F.ws + WS_CS; float* AA = (float*)(F.ws + WS_AA); float* BB = (float*)(F.ws + WS_BB); float* NL = (float*)(F.ws + WS_NL);
    float* ML = (float*)(F.ws + WS_ML); float* GC = (float*)(F.ws + WS_GC);
    LAS float* se = (LAS float*)(F.lds + 65536);
    const int w = F.wave, r = F.lane & 15, q = F.lane >> 4;
    const int rowl = 8 * q + (r >> 2);
    unsigned a2[8];
#pragma unroll
    for (int ct = 0; ct < 8; ++ct) a2[ct] = (unsigned)(off_tr2(rowl, 2 * ct + ((r & 3) >> 1)) + 8 * (r & 1));
    const unsigned a2k = (unsigned)(off_tr2(rowl, 2 * w + ((r & 3) >> 1)) + 8 * (r & 1));
    const int NU = NB * NH * NCH;
    u32x4 kreg[2], vreg[2]; const unsigned char* CVp = F.ws + WS_CV;
    int u = F.wg;
    if (u < NU) { const int c = u % NCH, h = (u / NCH) % NH, b = u / (NCH * NH), t0 = b * SEQ + c * CHK;
#pragma unroll
        for (int i = 0; i < 2; ++i) { const int cq = F.tid + NTHR * i, row = cq >> 3, cp = cq & 7; const unsigned char* src = CVp + (size_t)(t0 + row) * NCV + h * DH + cp * 16;
            kreg[i] = *(const u32x4*)(src + CK); vreg[i] = *(const u32x4*)(src + CVV); } }
    float* PM = (float*)(F.ws + WS_PM);
    for (int k = w; F.wg + k * F.G < NU && k < 16; k += NWAVES) {
        const int uu = F.wg + k * F.G, c = uu % NCH, h = (uu / NCH) % NH, b = uu / (NCH * NH), bh = b * NH + h, t0 = b * SEQ + c * CHK, ln = F.lane;
        const float f0 = GATES[(size_t)(t0 + ln) * 8 + 4 + h], i0 = GATES[(size_t)(t0 + ln) * 8 + h], f1 = GATES[(size_t)(t0 + 64 + ln) * 8 + 4 + h], i1 = GATES[(size_t)(t0 + 64 + ln) * 8 + h];
        const float a0 = wave_incl_scan_add(log_sigmoid(f0), ln); const float tot0 = rdlane(a0, 63);
        const float a1 = wave_incl_scan_add(log_sigmoid(f1), ln) + tot0; const float g = rdlane(a1, 63);
        const float b0 = i0 - a0, b1 = i1 - a1;
        const float m0 = wave_incl_scan_max(b0, ln); const float t0m = rdlane(m0, 63); const float m1 = fmaxf(wave_incl_scan_max(b1, ln), t0m); const float maxb = rdlane(m1, 63);
        const float sc = 0.08838834764831845f;
        se[k * 128 + ln] = expf(b0 - maxb) * sc; se[k * 128 + 64 + ln] = expf(b1 - maxb) * sc;
        const size_t o = (size_t)bh * SEQ + c * CHK + ln; AA[o] = a0; AA[o + 64] = a1; BB[o] = b0; BB[o + 64] = b1; PM[o] = m0; PM[o + 64] = m1;
        if (ln == 0) { ML[bh * NCH + c] = g + maxb; GC[bh * NCH + c] = g; }
    }
    bf16_t* Y = (bf16_t*)F.out; const unsigned char* CV = F.ws + WS_CV;
#define CV_LOAD8(dst, p_) do { const u32x2 w_ = *(const u32x2*)(p_); const f32x4 lo_ = unpack4_fp8(w_.x), hi_ = unpack4_fp8(w_.y); dst[0] = lo_[0]; dst[1] = lo_[1]; dst[2] = lo_[2]; dst[3] = lo_[3]; dst[4] = hi_[0]; dst[5] = hi_[1]; dst[6] = hi_[2]; dst[7] = hi_[3]; } while (0)
    const int ch0 = 8 * F.lane, ts = (F.wg * NWAVES + F.wave) * 32;
    float um1[8], um2[8];
    LAS float* cwl = (LAS float*)(F.lds + 65536 + 8192);
    for (int i = F.tid; i < 3 * 512; i += NTHR) cwl[i] = F.conv_w[(size_t)l * 3 * 512 + i];
#define CW_LOAD() float w0[8], w1[8], w2[8]; do { _Pragma("unroll") for (int qq = 0; qq < 2; ++qq) { const f32x4 a = *(LAS const f32x4*)(cwl + ch0 + 4 * qq), b = *(LAS const f32x4*)(cwl + 512 + ch0 + 4 * qq), c = *(LAS const f32x4*)(cwl + 1024 + ch0 + 4 * qq); \
          _Pragma("unroll") for (int j = 0; j < 4; ++j) { w0[4 * qq + j] = a[j]; w1[4 * qq + j] = b[j]; w2[4 * qq + j] = c[j]; } } } while (0)
    if ((ts % SEQ) == 0) {
#pragma unroll
        for (int i = 0; i < 8; ++i) { um1[i] = 0.f; um2[i] = 0.f; }
    } else { float a[8], b[8];
        CV_LOAD8(a, CV + (size_t)(ts - 1) * NCV + CU + ch0); CV_LOAD8(b, CV + (size_t)(ts - 2) * NCV + CU + ch0);
#pragma unroll
        for (int i = 0; i < 8; ++i) { um1[i] = a[i]; um2[i] = b[i]; } }
    __syncthreads();
    int kidx = 0;
    for (; u < NU; u += F.G, ++kidx) {
        const int c = u % NCH, h = (u / NCH) % NH, b = u / (NCH * NH), bh = b * NH + h, t0 = b * SEQ + c * CHK;
#pragma unroll
        for (int i = 0; i < 2; ++i) { const int cq = F.tid + NTHR * i, row = cq >> 3, cp = cq & 7;
            *(LAS u32x4*)(F.lds + off_tr2(row, 2 * cp)) = fp8x8_to_bf16x8((u32x2){kreg[i].x, kreg[i].y}); *(LAS u32x4*)(F.lds + off_tr2(row, 2 * cp + 1)) = fp8x8_to_bf16x8((u32x2){kreg[i].z, kreg[i].w});
            *(LAS u32x4*)(F.lds + 32768 + off_tr2(row, 2 * cp)) = fp8x8_to_bf16x8((u32x2){vreg[i].x, vreg[i].y}); *(LAS u32x4*)(F.lds + 32768 + off_tr2(row, 2 * cp + 1)) = fp8x8_to_bf16x8((u32x2){vreg[i].z, vreg[i].w}); }
        u32x2 cvr[4][3]; const bool cv_on = kidx < 8;
        if (cv_on) {
#pragma unroll
            for (int tt = 0; tt < 4; ++tt) { const unsigned char* pr = CV + (size_t)(ts + 4 * kidx + tt) * NCV + ch0; cvr[tt][0] = *(const u32x2*)(pr + CU); cvr[tt][2] = *(const u32x2*)(pr + CGB); } }
        { const int un = u + F.G;
          if (un < NU) { const int c2 = un % NCH, h2 = (un / NCH) % NH, b2 = un / (NCH * NH), t2 = b2 * SEQ + c2 * CHK;
#pragma unroll
            for (int i = 0; i < 2; ++i) { const int cq = F.tid + NTHR * i, row = cq >> 3, cp = cq & 7; const unsigned char* src = CVp + (size_t)(t2 + row) * NCV + h2 * DH + cp * 16;
                kreg[i] = *(const u32x4*)(src + CK); vreg[i] = *(const u32x4*)(src + CVV); }
 } }
        __syncthreads();
        f32x4 acc[8], nacc = (f32x4){0.f, 0.f, 0.f, 0.f};
#pragma unroll
        for (int vt = 0; vt < 8; ++vt) acc[vt] = (f32x4){0.f, 0.f, 0.f, 0.f};
        const bf16x8 ones = (bf16x8){(short)0x3F80, (short)0x3F80, (short)0x3F80, (short)0x3F80, (short)0x3F80, (short)0x3F80, (short)0x3F80, (short)0x3F80};
#pragma unroll
        for (int kk = 0; kk < 4; ++kk) {
            s16x4 k0, k1, vv[16]; TR_ISSUE_OFF(k0, a2k, kk * 8192); TR_ISSUE_OFF(k1, a2k, kk * 8192 + 1024);
#pragma unroll
            for (int vp = 0; vp < 4; ++vp) { TR_ISSUE_OFF(vv[4 * vp], a2[2 * vp], 32768 + kk * 8192); TR_ISSUE_OFF(vv[4 * vp + 1], a2[2 * vp], 32768 + kk * 8192 + 1024);
                TR_ISSUE_OFF(vv[4 * vp + 2], a2[2 * vp + 1], 32768 + kk * 8192); TR_ISSUE_OFF(vv[4 * vp + 3], a2[2 * vp + 1], 32768 + kk * 8192 + 1024); }
            const f32x4 e0 = *(LAS const f32x4*)(se + kidx * 128 + 32 * kk + 8 * q), e1 = *(LAS const f32x4*)(se + kidx * 128 + 32 * kk + 8 * q + 4);
            TR_WAIT2(k0, k1); TR_WAIT8(vv[0], vv[1], vv[2], vv[3], vv[4], vv[5], vv[6], vv[7]); TR_WAIT8(vv[8], vv[9], vv[10], vv[11], vv[12], vv[13], vv[14], vv[15]);
            float kf[8]; { u32x4 kw; const u32x2 lo = __builtin_bit_cast(u32x2, k0), hi = __builtin_bit_cast(u32x2, k1); kw.x = lo.x; kw.y = lo.y; kw.z = hi.x; kw.w = hi.y; unpack8(kw, kf); }
            kf[0] *= e0[0]; kf[1] *= e0[1]; kf[2] *= e0[2]; kf[3] *= e0[3]; kf[4] *= e1[0]; kf[5] *= e1[1]; kf[6] *= e1[2]; kf[7] *= e1[3];
            const bf16x8 kfs = __builtin_bit_cast(bf16x8, pack8(kf));
            nacc = __builtin_amdgcn_mfma_f32_16x16x32_bf16(ones, kfs, nacc, 0, 0, 0);
#pragma unroll
            for (int vp = 0; vp < 4; ++vp) {
                acc[2 * vp] = __builtin_amdgcn_mfma_f32_16x16x32_bf16(cat8(vv[4 * vp], vv[4 * vp + 1]), kfs, acc[2 * vp], 0, 0, 0);
                acc[2 * vp + 1] = __builtin_amdgcn_mfma_f32_16x16x32_bf16(cat8(vv[4 * vp + 2], vv[4 * vp + 3]), kfs, acc[2 * vp + 1], 0, 0, 0); }
        }
        MFMA_DRAIN();
        unsigned char* Cout = CS + ((size_t)bh * NCH + c) * (DH * DH) + (size_t)(16 * w + r) * DH + 16 * q;
#pragma unroll
        for (int g4 = 0; g4 < 2; ++g4) { unsigned x[4];
#pragma unroll
            for (int v = 0; v < 4; ++v) x[v] = pack4_fp8c(acc[4 * g4 + v], CL_SCALE);
            lane_row_transpose4(x);
            *(u32x4*)(Cout + 64 * g4) = (u32x4){x[0], x[1], x[2], x[3]}; }
        if (q == 0) NL[((size_t)bh * NCH + c) * DH + 16 * w + r] = nacc[0];
        if (cv_on) { CW_LOAD();
#pragma unroll
            for (int tt = 0; tt < 4; ++tt) { float y[8];
#pragma unroll
                for (int hf = 0; hf < 2; ++hf) {
                    const f32x4 uu4 = unpack4_fp8(hf ? cvr[tt][0].y : cvr[tt][0].x), gb4 = unpack4_fp8(hf ? cvr[tt][2].y : cvr[tt][2].x);
                    const f32x4 w04 = (f32x4){w0[4 * hf], w0[4 * hf + 1], w0[4 * hf + 2], w0[4 * hf + 3]}, w14 = (f32x4){w1[4 * hf], w1[4 * hf + 1], w1[4 * hf + 2], w1[4 * hf + 3]}, w24 = (f32x4){w2[4 * hf], w2[4 * hf + 1], w2[4 * hf + 2], w2[4 * hf + 3]};
                    const f32x4 u14 = (f32x4){um1[4 * hf], um1[4 * hf + 1], um1[4 * hf + 2], um1[4 * hf + 3]}, u24 = (f32x4){um2[4 * hf], um2[4 * hf + 1], um2[4 * hf + 2], um2[4 * hf + 3]};
                    const f32x4 y4 = gb4 * (w24 * uu4 + w14 * u14 + w04 * u24);
#pragma unroll
                    for (int i = 0; i < 4; ++i) { y[4 * hf + i] = y4[i]; um2[4 * hf + i] = um1[4 * hf + i]; um1[4 * hf + i] = uu4[i]; } }
                { u32x2 yw; yw.x = pack4_fp8c((f32x4){y[0], y[1], y[2], y[3]}, Y_SCALE); yw.y = pack4_fp8c((f32x4){y[4], y[5], y[6], y[7]}, Y_SCALE); *(u32x2*)((unsigned char*)Y + (size_t)(ts + 4 * kidx + tt) * D + 512 + ch0) = yw; } } }
        __syncthreads();
    }
    if (kidx > 8) kidx = 8;
    for (int tcur = ts + 4 * kidx; tcur < ts + 32; ++tcur) { CW_LOAD(); float gc[8], xc[8], gb[8], y[8]; const unsigned char* pr = CV + (size_t)tcur * NCV + ch0;
        CV_LOAD8(gc, pr + CU); CV_LOAD8(gb, pr + CGB); (void)xc;
#pragma unroll
        for (int i = 0; i < 8; ++i) { const float uu = gc[i]; y[i] = gb[i] * (w2[i] * uu + w1[i] * um1[i] + w0[i] * um2[i]); um2[i] = um1[i]; um1[i] = uu; }
        { u32x2 yw; yw.x = pack4_fp8c((f32x4){y[0], y[1], y[2], y[3]}, Y_SCALE); yw.y = pack4_fp8c((f32x4){y[4], y[5], y[6], y[7]}, Y_SCALE); *(u32x2*)((unsigned char*)Y + (size_t)tcur * D + 512 + ch0) = yw; } }
#undef CV_LOAD8
#undef CW_LOAD
}

__device__ __forceinline__ void p3_scan(const Ctx& F) {
    const unsigned char* CS = F.ws + WS_CS; const float* NL = (const float*)(F.ws + WS_NL); float* NST = (float*)(F.ws + WS_NST); const float* ML = (const float*)(F.ws + WS_ML); const float* GC = (const float*)(F.ws + WS_GC); float* MST = (float*)(F.ws + WS_MST);
    unsigned char* CSB = (unsigned char*)F.out + CSB_OFF;
    static_assert(NCH == 64, "lane c of wave 0 keeps chunk c");
    LAS float* ssp = (LAS float*)F.lds; LAS float* ssl = ssp + NCH;
    for (int it0 = F.wg * NTHR; it0 < 32 * 4096; it0 += F.G * NTHR) {
        const int bh = __builtin_amdgcn_readfirstlane(it0 >> 12), e4 = (it0 & 4095) + F.tid;
        const unsigned* cp = (const unsigned*)(CS + (size_t)bh * NCH * (DH * DH)) + e4; unsigned* op = (unsigned*)(CSB + (size_t)bh * NCH * (DH * DH)) + e4;
        const bool do_n = e4 < DH;
        unsigned cw[NCH]; float vn[NCH];
#pragma unroll
        for (int c = 0; c < NCH; ++c) cw[c] = cp[(size_t)c * 4096];
#pragma unroll
        for (int c = 0; c < NCH; ++c) vn[c] = 0.f;
        if (do_n) {
#pragma unroll
            for (int c = 0; c < NCH; ++c) vn[c] = NL[((size_t)bh * NCH + c) * DH + e4]; }
        __syncthreads();
        if (F.wave == 0) {
            const float mlv = ML[bh * NCH + F.lane], gcv = GC[bh * NCH + F.lane];
            float mprev = 0.f, my_sp = 0.f, my_sl = 0.f, my_m = 0.f;
#pragma unroll
            for (int c = 0; c < NCH; ++c) { const float ml = rdlane(mlv, c), gc = rdlane(gcv, c);
                const float mnew = fmaxf(gc + mprev, ml), sp = __expf(gc + mprev - mnew), sl = __expf(ml - mnew);
                if (F.lane == c) { my_sp = sp; my_sl = sl; my_m = mprev; }
                mprev = mnew; }
            ssp[F.lane] = my_sp; ssl[F.lane] = my_sl; MST[bh * NCH + F.lane] = my_m; }
        __syncthreads();
        f32x4 st = (f32x4){0.f, 0.f, 0.f, 0.f}; float sn = 0.f;
#pragma unroll
        for (int c = 0; c < NCH; ++c) { const float sp = ssp[c], sl = ssl[c];
            op[(size_t)c * 4096] = pack4_fp8c(st, CS_SCALE); if (do_n) NST[((size_t)bh * NCH + c) * DH + e4] = sn;
            const f32x4 v_ = unpack4_fp8(cw[c]) * (1.0f / CL_SCALE);
            st = st * sp + v_ * sl; sn = sn * sp + vn[c] * sl; }
    }
}

__device__ __forceinline__ int off_trv(int row, int ch) { return row * 256 + ((ch ^ (2 * (row & 7))) << 4); }
__device__ __forceinline__ int off_row(int row, int ch) { return row * 256 + ((ch ^ (row & 15)) << 4); }
__device__ __forceinline__ void p4_mlstm_out(const Ctx& F, int l) {
    const unsigned char* WSB = F.ws; const unsigned char* OUTB = (const unsigned char*)F.out;
#define P4_WS16(off_) (*(const u32x4*)(WSB + (unsigned)(off_)))
#define P4_WSF(off_) (*(const float*)(WSB + (unsigned)(off_)))
#define P4_WS8(off_) (*(const u32x2*)(WSB + (unsigned)(off_)))
#define P4_OUT16(off_) (*(const u32x4*)(OUTB + (unsigned)(off_)))
    const unsigned char* CSB = (const unsigned char*)F.out + CSB_OFF;
    const float* AA = (const float*)(F.ws + WS_AA); const float* BB = (const float*)(F.ws + WS_BB); const float* PM = (const float*)(F.ws + WS_PM);
    const float* NL = (const float*)(F.ws + WS_NST); const float* MST = (const float*)(F.ws + WS_MST); bf16_t* Y = (bf16_t*)F.out;
    LAS float* sa = (LAS float*)(F.lds + 98304); LAS float* sb_ = sa + 128; LAS float* sM = sa + 256; LAS float* sn = sa + 384; LAS float* smg = sa + 512;
    smg[F.tid] = F.mh_g[(size_t)l * 512 + F.tid];
    LAS float* slut = sa + 1024;
    if (F.tid < 256) { const f32x2 cv = __builtin_amdgcn_cvt_pk_f32_fp8(F.tid, false); slut[F.tid] = sigmoidf_(cv[0]); }
    const int w = F.wave < 4 ? F.wave : 11 - F.wave, r = F.lane & 15, q = F.lane >> 4;
    const int rowl = 4 * q + (r >> 2);
    unsigned av[8];
#pragma unroll
    for (int vt = 0; vt < 8; ++vt) av[vt] = (unsigned)(off_trv(rowl, 2 * vt + ((r & 3) >> 1)) + 8 * (r & 1));
    unsigned ak[4];
#pragma unroll
    for (int kk = 0; kk < 4; ++kk) ak[kk] = (unsigned)(65536 + 256 * r + 16 * ((4 * kk + q) ^ r));
    const int NU = NB * NH * NCH;
    u32x4 kreg[2], vreg[2], creg[2]; u32x2 qraw[4];
    const unsigned char* CVp = F.ws + WS_CV; float spre[8] = {0.f, 0.f, 0.f, 0.f, 0.f, 0.f, 0.f, 0.f}; float mst_n = 0.f;
#define P4_SMALL(bh_, c_) do { mst_n = P4_WSF((unsigned)WS_MST + (unsigned)((bh_) * NCH + (c_)) * 4u); if (w == 0) { const unsigned o_ = (unsigned)((bh_) * SEQ + (c_) * CHK + F.lane) * 4u; spre[0] = P4_WSF((unsigned)WS_AA + o_); spre[1] = P4_WSF((unsigned)WS_AA + o_ + 256u); spre[2] = P4_WSF((unsigned)WS_BB + o_); spre[3] = P4_WSF((unsigned)WS_BB + o_ + 256u); \
        const unsigned n_ = (unsigned)(((bh_) * NCH + (c_)) * DH + F.lane) * 4u; spre[4] = P4_WSF((unsigned)WS_NST + n_); spre[5] = P4_WSF((unsigned)WS_NST + n_ + 256u); spre[6] = P4_WSF((unsigned)WS_PM + o_); spre[7] = P4_WSF((unsigned)WS_PM + o_ + 256u); } } while (0)
    int u = F.wg;
    if (u < NU) { const int c = u % NCH, h = (u / NCH) % NH, b = u / (NCH * NH), bh = b * NH + h, t0 = b * SEQ + c * CHK;
        P4_SMALL(bh, c);
#pragma unroll
        for (int i = 0; i < 2; ++i) { const int cq = F.tid + NTHR * i, row = cq >> 3, cp = cq & 7; kreg[i] = P4_WS16((unsigned)WS_CV + (unsigned)((t0 + row) * NCV + CK + h * DH + cp * 16)); }
#pragma unroll
        for (int i = 0; i < 2; ++i) { const int cq = F.tid + NTHR * i, row = cq >> 3, cp = cq & 7;
            vreg[i] = P4_WS16((unsigned)WS_CV + (unsigned)((t0 + row) * NCV + CVV + h * DH + cp * 16));
            creg[i] = P4_OUT16((unsigned)CSB_OFF + (unsigned)((bh * NCH + c) * (DH * DH) + row * DH + cp * 16)); }
#pragma unroll
        for (int kk = 0; kk < 4; ++kk) qraw[kk] = P4_WS8((unsigned)WS_CV + (unsigned)((t0 + 16 * w + r) * NCV + CQ + h * DH + 32 * kk + 8 * q)); }
    for (; u < NU; u += F.G) {
        const int c = u % NCH, h = (u / NCH) % NH, b = u / (NCH * NH), bh = b * NH + h, t0 = b * SEQ + c * CHK;
        const float mst = mst_n;
#pragma unroll
        for (int i = 0; i < 2; ++i) { const int cq = F.tid + NTHR * i, row = cq >> 3, cp = cq & 7;
            *(LAS u32x4*)(F.lds + 65536 + off_row(row, 2 * cp)) = fp8x8_to_bf16x8((u32x2){kreg[i].x, kreg[i].y}); *(LAS u32x4*)(F.lds + 65536 + off_row(row, 2 * cp + 1)) = fp8x8_to_bf16x8((u32x2){kreg[i].z, kreg[i].w}); }
#pragma unroll
        for (int i = 0; i < 2; ++i) { const int cq = F.tid + NTHR * i, row = cq >> 3, cp = cq & 7;
            const int rho = (row & ~31) | ((row & 4) << 2) | ((row >> 1) & 12) | (row & 3);
            *(LAS u32x4*)(F.lds + off_trv(row, 2 * cp)) = fp8x8_to_bf16x8((u32x2){vreg[i].x, vreg[i].y}); *(LAS u32x4*)(F.lds + off_trv(row, 2 * cp + 1)) = fp8x8_to_bf16x8((u32x2){vreg[i].z, vreg[i].w});
            *(LAS u32x4*)(F.lds + 32768 + off_trv(rho, 2 * cp)) = fp8x8_to_bf16x8((u32x2){creg[i].x, creg[i].y}); *(LAS u32x4*)(F.lds + 32768 + off_trv(rho, 2 * cp + 1)) = fp8x8_to_bf16x8((u32x2){creg[i].z, creg[i].w}); }
        if (w == 0) { const int ln = F.lane;
            sa[ln] = spre[0]; sa[64 + ln] = spre[1]; sb_[ln] = spre[2]; sb_[64 + ln] = spre[3]; sM[ln] = fmaxf(spre[6], mst); sM[64 + ln] = fmaxf(spre[7], mst);
            sn[ln] = spre[4]; sn[64 + ln] = spre[5]; }
        { const int un = u + F.G;
          if (un < NU) { const int c2 = un % NCH, h2 = (un / NCH) % NH, b2 = un / (NCH * NH), bh2 = b2 * NH + h2, t2 = b2 * SEQ + c2 * CHK;
#pragma unroll
            for (int i = 0; i < 2; ++i) { const int cq = F.tid + NTHR * i, row = cq >> 3, cp = cq & 7; kreg[i] = P4_WS16((unsigned)WS_CV + (unsigned)((t2 + row) * NCV + CK + h2 * DH + cp * 16)); }
#pragma unroll
            for (int i = 0; i < 2; ++i) { const int cq = F.tid + NTHR * i, row = cq >> 3, cp = cq & 7;
                vreg[i] = P4_WS16((unsigned)WS_CV + (unsigned)((t2 + row) * NCV + CVV + h2 * DH + cp * 16));
                creg[i] = P4_OUT16((unsigned)CSB_OFF + (unsigned)((bh2 * NCH + c2) * (DH * DH) + row * DH + cp * 16)); }
            P4_SMALL(bh2, c2); } }
        u32x4 qf[4];
#pragma unroll
        for (int kk = 0; kk < 4; ++kk) qf[kk] = fp8x8_to_bf16x8(qraw[kk]);
        const bf16x8 q0 = __builtin_bit_cast(bf16x8, qf[0]), q1 = __builtin_bit_cast(bf16x8, qf[1]), q2 = __builtin_bit_cast(bf16x8, qf[2]), q3 = __builtin_bit_cast(bf16x8, qf[3]);
        __syncthreads();
        const int j = 16 * w + r; const float Mj = sM[j], aj = sa[j];
        float qn = 0.f;
#pragma unroll
        for (int kk = 0; kk < 4; ++kk) { float qv[8]; unpack8(qf[kk], qv);
            const f32x4 n0 = *(LAS const f32x4*)(sn + 32 * kk + 8 * q), n1 = *(LAS const f32x4*)(sn + 32 * kk + 8 * q + 4);
            qn += qv[0] * n0[0] + qv[1] * n0[1] + qv[2] * n0[2] + qv[3] * n0[3] + qv[4] * n1[0] + qv[5] * n1[1] + qv[6] * n1[2] + qv[7] * n1[3]; }
        float rs = 0.f; bf16x8 pf[4];
#pragma unroll
        for (int k2 = 0; k2 < 4; ++k2) {
            u32x4 pw = (u32x4){0u, 0u, 0u, 0u};
            if (2 * k2 <= w) {
                float pv[2][4]; f32x4 sacc[2]; const bool two = (2 * k2 + 1 <= w);
#pragma unroll
                for (int hh = 0; hh < 2; ++hh) { const int n = 2 * k2 + hh; sacc[hh] = (f32x4){0.f, 0.f, 0.f, 0.f};
                    if (hh == 0 || two) {
                        const bf16x8 k0 = *(const LAS bf16x8*)(F.lds + ak[0] + 4096 * n), k1 = *(const LAS bf16x8*)(F.lds + ak[1] + 4096 * n), k2f = *(const LAS bf16x8*)(F.lds + ak[2] + 4096 * n), k3 = *(const LAS bf16x8*)(F.lds + ak[3] + 4096 * n);
                        sacc[hh] = __builtin_amdgcn_mfma_f32_16x16x32_bf16(k0, q0, sacc[hh], 0, 0, 0); sacc[hh] = __builtin_amdgcn_mfma_f32_16x16x32_bf16(k1, q1, sacc[hh], 0, 0, 0);
                        sacc[hh] = __builtin_amdgcn_mfma_f32_16x16x32_bf16(k2f, q2, sacc[hh], 0, 0, 0); sacc[hh] = __builtin_amdgcn_mfma_f32_16x16x32_bf16(k3, q3, sacc[hh], 0, 0, 0); } }
                MFMA_DRAIN();
#pragma unroll
                for (int hh = 0; hh < 2; ++hh) { const int n = 2 * k2 + hh;
                    if (hh == 0 || two) { const f32x4 bv = *(LAS const f32x4*)(sb_ + 16 * n + 4 * q);
                        const f32x4 d4 = (bv - Mj) * 1.4426950408889634f;
                        const f32x4 e4 = (f32x4){__builtin_amdgcn_exp2f(d4[0]), __builtin_amdgcn_exp2f(d4[1]), __builtin_amdgcn_exp2f(d4[2]), __builtin_amdgcn_exp2f(d4[3])};
                        const f32x4 val4 = (sacc[hh] * 0.08838834764831845f) * e4;
#pragma unroll
                        for (int t = 0; t < 4; ++t) { float val = val4[t]; if (n == w && (4 * q + t) > r) val = 0.f; rs += val; pv[hh][t] = val; } }
                    else {
#pragma unroll
                        for (int t = 0; t < 4; ++t) pv[hh][t] = 0.f; } }
                pw.x = pk2(pv[0][0], pv[0][1]); pw.y = pk2(pv[0][2], pv[0][3]); pw.z = pk2(pv[1][0], pv[1][1]); pw.w = pk2(pv[1][2], pv[1][3]);
            }
            pf[k2] = __builtin_bit_cast(bf16x8, pw); }
        rs = sum_rows4(rs); qn = sum_rows4(qn);
        f32x4 acc[8];
#pragma unroll
        for (int vt = 0; vt < 8; ++vt) acc[vt] = (f32x4){0.f, 0.f, 0.f, 0.f};
#pragma unroll
        for (int kk = 0; kk < 4; ++kk) { const bf16x8 qb = kk == 0 ? q0 : kk == 1 ? q1 : kk == 2 ? q2 : q3;
            s16x4 cc[16];
#pragma unroll
            for (int vh = 0; vh < 2; ++vh)
#pragma unroll
                for (int i = 0; i < 4; ++i) { TR_ISSUE_OFF(cc[8 * vh + 2 * i], av[4 * vh + i], 32768 + kk * 8192); TR_ISSUE_OFF(cc[8 * vh + 2 * i + 1], av[4 * vh + i], 32768 + kk * 8192 + 4096); }
            TR_WAIT8(cc[0], cc[1], cc[2], cc[3], cc[4], cc[5], cc[6], cc[7]); TR_WAIT8(cc[8], cc[9], cc[10], cc[11], cc[12], cc[13], cc[14], cc[15]);
#pragma unroll
            for (int vt = 0; vt < 8; ++vt) acc[vt] = __builtin_amdgcn_mfma_f32_16x16x32_bf16(cat8(cc[2 * vt], cc[2 * vt + 1]), qb, acc[vt], 0, 0, 0); }
        MFMA_DRAIN();
        const float ei = __expf(mst - Mj); const float eis = ei * (1.0f / CS_SCALE);
#pragma unroll
        for (int vt = 0; vt < 8; ++vt) acc[vt] = acc[vt] * eis;
        { const int un = u + F.G;
          if (un < NU) { const int c2 = un % NCH, h2 = (un / NCH) % NH, b2 = un / (NCH * NH), t2 = b2 * SEQ + c2 * CHK;
#pragma unroll
            for (int kk = 0; kk < 4; ++kk) qraw[kk] = P4_WS8((unsigned)WS_CV + (unsigned)((t2 + 16 * w + r) * NCV + CQ + h2 * DH + 32 * kk + 8 * q)); } }
        u32x4 ogw[2];
#pragma unroll
        for (int g4 = 0; g4 < 2; ++g4) ogw[g4] = P4_WS16((unsigned)WS_CV + (unsigned)((t0 + 16 * w + r) * NCV + CO + h * DH + 64 * g4 + 16 * q));
#pragma unroll
        for (int k2 = 0; k2 < 4; ++k2) {
            if (k2 <= (w >> 1)) { s16x4 vv[16];
#pragma unroll
                for (int vh = 0; vh < 2; ++vh)
#pragma unroll
                    for (int i = 0; i < 4; ++i) { TR_ISSUE_OFF(vv[8 * vh + 2 * i], av[4 * vh + i], k2 * 8192); TR_ISSUE_OFF(vv[8 * vh + 2 * i + 1], av[4 * vh + i], k2 * 8192 + 4096); }
                TR_WAIT8(vv[0], vv[1], vv[2], vv[3], vv[4], vv[5], vv[6], vv[7]); TR_WAIT8(vv[8], vv[9], vv[10], vv[11], vv[12], vv[13], vv[14], vv[15]);
#pragma unroll
                for (int vt = 0; vt < 8; ++vt) acc[vt] = __builtin_amdgcn_mfma_f32_16x16x32_bf16(cat8(vv[2 * vt], vv[2 * vt + 1]), pf[k2], acc[vt], 0, 0, 0); } }
        MFMA_DRAIN();
        const float den = rs + ei * qn; const float inv = __builtin_amdgcn_rcpf(fmaxf(fabsf(den), __expf(-aj - Mj)));
        float s1 = 0.f;
#pragma unroll
        for (int vt = 0; vt < 8; ++vt) acc[vt] = acc[vt] * inv;
        { f32x4 s4 = acc[0];
#pragma unroll
          for (int vt = 1; vt < 8; ++vt) s4 += acc[vt];
          s1 = (s4[0] + s4[1]) + (s4[2] + s4[3]); }
        s1 = sum_rows4(s1);
        const float mean = s1 * (1.0f / DH); float s2 = 0.f;
        { f32x4 q4 = (f32x4){0.f, 0.f, 0.f, 0.f};
#pragma unroll
          for (int vt = 0; vt < 8; ++vt) { acc[vt] = acc[vt] - mean; q4 += acc[vt] * acc[vt]; }
          s2 = (q4[0] + q4[1]) + (q4[2] + q4[3]); }
        s2 = sum_rows4(s2);
        const float rstd = __builtin_amdgcn_rsqf(s2 * (1.0f / DH) + LN_EPS);
        LAS const float* gp = smg + h * DH + 4 * q; unsigned char* yp = (unsigned char*)F.out + (unsigned)((t0 + j) * D + h * DH + 16 * q);
#pragma unroll
        for (int g4 = 0; g4 < 2; ++g4) { unsigned og[4] = {ogw[g4].x, ogw[g4].y, ogw[g4].z, ogw[g4].w}; lane_row_transpose4(og);
            unsigned yw[4];
#pragma unroll
            for (int v = 0; v < 4; ++v) { const int vt = 4 * g4 + v; const f32x4 g4v = *(LAS const f32x4*)(gp + 16 * vt);
                const unsigned ow = og[v];
                const f32x4 sg = (f32x4){*(LAS const float*)((LAS const char*)slut + ((ow << 2) & 0x3fcu)), *(LAS const float*)((LAS const char*)slut + ((ow >> 6) & 0x3fcu)),
                                         *(LAS const float*)((LAS const char*)slut + ((ow >> 14) & 0x3fcu)), *(LAS const float*)((LAS const char*)slut + ((ow >> 22) & 0x3fcu))};
                const f32x4 y4 = (acc[vt] * rstd) * (g4v * sg);
                yw[v] = pack4_fp8c(y4, Y_SCALE); }
            lane_row_transpose4(yw);
            *(u32x4*)(yp + 64 * g4) = (u32x4){yw[0], yw[1], yw[2], yw[3]}; }
        __syncthreads();
    }
#undef P4_SMALL
#undef P4_WS16
#undef P4_WSF
#undef P4_WS8
#undef P4_OUT16
}

__device__ __forceinline__ void route_select(const float (&lg)[16], int& be0, int& be1, float& g0, float& g1) {
    float mx = lg[0];
#pragma unroll
    for (int e = 1; e < 16; ++e) mx = fmaxf(mx, lg[e]);
    float p[16];
#pragma unroll
    for (int e = 0; e < 16; ++e) p[e] = expf(lg[e] - mx);
    float best = -1.f, bp0 = 0.f, bp1 = 0.f; be0 = 0; be1 = 1;
#pragma unroll
    for (int g = 0; g < 4; ++g) { const float a0 = p[4 * g], a1 = p[4 * g + 1], a2 = p[4 * g + 2], a3 = p[4 * g + 3];
        int i0 = 0; float v0 = a0; if (a1 > v0) { v0 = a1; i0 = 1; } if (a2 > v0) { v0 = a2; i0 = 2; } if (a3 > v0) { v0 = a3; i0 = 3; }
        int i1 = 0; float v1 = -1.f;
        if (i0 != 0 && a0 > v1) { v1 = a0; i1 = 0; } if (i0 != 1 && a1 > v1) { v1 = a1; i1 = 1; } if (i0 != 2 && a2 > v1) { v1 = a2; i1 = 2; } if (i0 != 3 && a3 > v1) { v1 = a3; i1 = 3; }
        const float sg = v0 + v1; if (sg > best) { best = sg; be0 = 4 * g + i0; be1 = 4 * g + i1; bp0 = v0; bp1 = v1; } }
    const float inv = 1.0f / (bp0 + bp1); g0 = bp0 * inv; g1 = bp1 * inv;
}
__device__ __forceinline__ void p6_ln_router(const Ctx& F, int l, int cbank) {
    const bf16_t* PRE = (const bf16_t*)(F.ws + WS_PRE); bf16_t* X = (bf16_t*)(F.ws + WS_X);
    int* TL = (int*)(F.ws + WS_TLIST); float* GL = (float*)(F.ws + WS_GLIST);
    unsigned* CNT = (unsigned*)(F.ws + WS_CTL) + CW_CNT + 64 * cbank;
    LAS u32x4* fb = (LAS u32x4*)F.lds;
    LAS float* gt = (LAS float*)(F.lds + 65536); LAS float* bt = gt + 1024;
    LAS int* lcnt = (LAS int*)(F.lds + 73728); LAS int* lbase = lcnt + 16; LAS int* rec = (LAS int*)(F.lds + 73728 + 256);
    LAS float* lgw = (LAS float*)(F.lds + 73728 + 256 + 16384) + F.wave * 256;
    const int r = F.lane & 15, q = F.lane >> 4;
    const int rpw = (M + F.G - 1) / F.G, r0 = F.wg * rpw;
    u32x4 raw[32];
    if (F.wave < rpw / 16) { const bf16_t* rowp = PRE + (size_t)(r0 + 16 * F.wave + r) * D + 8 * q;
#pragma unroll
        for (int kk = 0; kk < 32; ++kk) raw[kk] = *(const u32x4*)(rowp + 32 * kk); }
    { const u32x4* RFB = (const u32x4*)(F.ws + WS_RFB);
#pragma unroll
      for (int j = 0; j < 8; ++j) fb[F.tid + NTHR * j] = RFB[F.tid + NTHR * j]; }
    for (int i = F.tid; i < D; i += NTHR) { gt[i] = F.ln_mix_g[(size_t)l * D + i]; bt[i] = F.ln_mix_b[(size_t)l * D + i]; }
    if (F.tid < 16) lcnt[F.tid] = 0;
    __syncthreads();
    float rb[16];
#pragma unroll
    for (int e = 0; e < 16; ++e) rb[e] = F.router_b[e];
    for (int grp = F.wave; grp < rpw / 16; grp += NWAVES) {
        const int rl0 = 16 * grp; unsigned char* xf = (unsigned char*)F.out + X1F_OFF + (size_t)(r0 + rl0 + r) * D + 8 * q;
        float s1 = 0.f, s2 = 0.f;
#pragma unroll
        for (int kk = 0; kk < 32; ++kk) { float v[8]; unpack8(raw[kk], v);
#pragma unroll
            for (int i = 0; i < 8; ++i) { s1 += v[i]; s2 += v[i] * v[i]; } }
        s1 = sum_rows4(s1); s2 = sum_rows4(s2);
        const float mean = s1 * (1.0f / D); const float rstd = __builtin_amdgcn_rsqf(fmaxf(s2 * (1.0f / D) - mean * mean, 0.f) + LN_EPS);
        if (q == 0) *(f32x2*)(F.ws + WS_RE + (size_t)(r0 + rl0 + r) * 8) = (f32x2){mean, rstd};
#pragma unroll
        for (int kk = 0; kk < 32; ++kk) asm volatile("" : "+v"(raw[kk]));
        f32x4 acc = (f32x4){0.f, 0.f, 0.f, 0.f}; u32x2 f8prev = (u32x2){0u, 0u};
#pragma unroll
        for (int kk = 0; kk < 32; ++kk) { float v[8], x1[8], xl[8]; unpack8(raw[kk], v);
            const f32x4 g0 = *(LAS const f32x4*)(gt + 32 * kk + 8 * q), g1 = *(LAS const f32x4*)(gt + 32 * kk + 8 * q + 4), b0 = *(LAS const f32x4*)(bt + 32 * kk + 8 * q), b1 = *(LAS const f32x4*)(bt + 32 * kk + 8 * q + 4);
#pragma unroll
            for (int i = 0; i < 4; ++i) { x1[i] = (v[i] - mean) * rstd * g0[i] + b0[i]; x1[4 + i] = (v[4 + i] - mean) * rstd * g1[i] + b1[i]; }
            const u32x4 hi = pack8(x1);
            { u32x2 f8; f8.x = pack4_fp8c((f32x4){x1[0], x1[1], x1[2], x1[3]}, 1.0f); f8.y = pack4_fp8c((f32x4){x1[4], x1[5], x1[6], x1[7]}, 1.0f);
              if (kk & 1) *(u32x4*)(xf - 8 * q + 32 * (kk - 1) + (q & 1) * 32 + 8 * (q & ~1)) = widen_fp8_pair(f8prev, f8); else f8prev = f8; }
            float hf[8]; unpack8(hi, hf);
#pragma unroll
            for (int i = 0; i < 8; ++i) xl[i] = x1[i] - hf[i];
            const bf16x8 ah = __builtin_bit_cast(bf16x8, hi), al = __builtin_bit_cast(bf16x8, pack8(xl));
            const bf16x8 bh = __builtin_bit_cast(bf16x8, fb[(kk * 2) * 64 + F.lane]), blo = __builtin_bit_cast(bf16x8, fb[(kk * 2 + 1) * 64 + F.lane]);
            acc = __builtin_amdgcn_mfma_f32_16x16x32_bf16(ah, bh, acc, 0, 0, 0);
            acc = __builtin_amdgcn_mfma_f32_16x16x32_bf16(al, bh, acc, 0, 0, 0);
            acc = __builtin_amdgcn_mfma_f32_16x16x32_bf16(ah, blo, acc, 0, 0, 0);
            MFMA_DRAIN(); }
        if (grp + NWAVES < rpw / 16) { const bf16_t* rowp = PRE + (size_t)(r0 + 16 * (grp + NWAVES) + r) * D + 8 * q;
#pragma unroll
            for (int kk = 0; kk < 32; ++kk) raw[kk] = *(const u32x4*)(rowp + 32 * kk); }
#pragma unroll
        for (int t = 0; t < 4; ++t) lgw[(4 * q + t) * 16 + r] = acc[t];
        LDS_WAIT(); asm volatile("" ::: "memory");
        if (F.lane < 16) {
            float lg[16];
#pragma unroll
            for (int q4 = 0; q4 < 4; ++q4) { const f32x4 t4 = *(LAS const f32x4*)(lgw + 16 * F.lane + 4 * q4); lg[4 * q4] = t4[0] + rb[4 * q4]; lg[4 * q4 + 1] = t4[1] + rb[4 * q4 + 1]; lg[4 * q4 + 2] = t4[2] + rb[4 * q4 + 2]; lg[4 * q4 + 3] = t4[3] + rb[4 * q4 + 3]; }
            int e0, e1; float g0, g1; route_select(lg, e0, e1, g0, g1);
            const int rr = rl0 + F.lane;
            const int s0 = atomicAdd((int*)lcnt + e0, 1), s1_ = atomicAdd((int*)lcnt + e1, 1);
            rec[rr * 8 + 0] = e0; rec[rr * 8 + 1] = e1; rec[rr * 8 + 2] = s0; rec[rr * 8 + 3] = s1_; rec[rr * 8 + 4] = __float_as_int(g0); rec[rr * 8 + 5] = __float_as_int(g1); }
        LDS_WAIT(); asm volatile("" ::: "memory");
    }
    __syncthreads();
    if (F.tid < 16) lbase[F.tid] = (int)__hip_atomic_fetch_add(CNT + F.tid, (unsigned)lcnt[F.tid], RLX_AGENT);
    __syncthreads();
    for (int rr = F.tid; rr < rpw; rr += NTHR) { const int m = r0 + rr; if (m >= M) break;
        const int e0 = rec[rr * 8 + 0], e1 = rec[rr * 8 + 1], s0 = lbase[e0] + rec[rr * 8 + 2], s1 = lbase[e1] + rec[rr * 8 + 3];
        TL[(size_t)e0 * M + s0] = 2 * m; TL[(size_t)e1 * M + s1] = 2 * m + 1;   GL[(size_t)e0 * M + s0] = __int_as_float(rec[rr * 8 + 4]); GL[(size_t)e1 * M + s1] = __int_as_float(rec[rr * 8 + 5]); }
}

__device__ __forceinline__ void moe_tables(const Ctx& F, int l) {
    LAS int* tab = (LAS int*)(F.lds + MISC_OFF + 64);
    unsigned* CNT = (unsigned*)(F.ws + WS_CTL) + CW_CNT + 64 * l;
    __syncthreads();
    if (F.tid < 16) tab[F.tid] = (int)__hip_atomic_load(CNT + F.tid, RLX_AGENT);
    __syncthreads();
    if (F.tid == 0) { int s = 0;
        for (int e = 0; e < 16; ++e) { tab[16 + e] = s; s += (tab[e] + 255) >> 8; }
        tab[32] = s; }
    __syncthreads();
}

__device__ __forceinline__ void ln_inplace_lds2(f32x2 (&v)[8], LAS const float* gb, int lane) {
    f32x2 s2 = v[0];
#pragma unroll
    for (int p = 1; p < 8; ++p) s2 += v[p];
    const float mean = wave_sum(s2[0] + s2[1], lane) * (1.0f / D); const f32x2 m2 = (f32x2){mean, mean}; f32x2 q2 = (f32x2){0.f, 0.f};
#pragma unroll
    for (int p = 0; p < 8; ++p) { v[p] -= m2; q2 += v[p] * v[p]; }
    const float rstd = __builtin_amdgcn_rsqf(wave_sum(q2[0] + q2[1], lane) * (1.0f / D) + LN_EPS); const f32x2 r2 = (f32x2){rstd, rstd};
#pragma unroll
    for (int hh = 0; hh < 4; ++hh) { const f32x4 g4 = *(LAS const f32x4*)(gb + hh * 256 + lane * 4), b4 = *(LAS const f32x4*)(gb + (4 + hh) * 256 + lane * 4);
        v[2 * hh] = v[2 * hh] * (r2 * (f32x2){g4[0], g4[1]}) + (f32x2){b4[0], b4[1]}; v[2 * hh + 1] = v[2 * hh + 1] * (r2 * (f32x2){g4[2], g4[3]}) + (f32x2){b4[2], b4[3]}; }
}
template <int NJ> __device__ __forceinline__ void row_dots2(const f32x2 (&v)[2][8], LAS const float* tab, int lane, float (&out)[2 * NJ]) {
#pragma unroll
    for (int j = 0; j < NJ; ++j) { f32x2 s0 = (f32x2){0.f, 0.f}, s1 = (f32x2){0.f, 0.f};
#pragma unroll
        for (int hh = 0; hh < 4; ++hh) { const f32x4 w = *(LAS const f32x4*)(tab + (j * 4 + hh) * 256 + lane * 4); const f32x2 w01 = (f32x2){w[0], w[1]}, w23 = (f32x2){w[2], w[3]};
            s0 += v[0][2 * hh] * w01; s0 += v[0][2 * hh + 1] * w23; s1 += v[1][2 * hh] * w01; s1 += v[1][2 * hh + 1] * w23; }
        out[j] = s0[0] + s0[1]; out[NJ + j] = s1[0] + s1[1]; }
}
__device__ __forceinline__ void store_row_bf16_2(bf16_t* row, int lane, const f32x2 (&v)[8]) {
    u32x4 a, b; a.x = pk2(v[0][0], v[0][1]); a.y = pk2(v[1][0], v[1][1]); a.z = pk2(v[2][0], v[2][1]); a.w = pk2(v[3][0], v[3][1]);
    b.x = pk2(v[4][0], v[4][1]); b.y = pk2(v[5][0], v[5][1]); b.z = pk2(v[6][0], v[6][1]); b.w = pk2(v[7][0], v[7][1]);
    *(u32x4*)(row + 8 * lane) = a; *(u32x4*)(row + 512 + 8 * lane) = b;
}
__device__ __forceinline__ void store_row_f32_2(float* row, int lane, const f32x2 (&v)[8]) {
#pragma unroll
    for (int j = 0; j < 2; ++j)
#pragma unroll
        for (int q = 0; q < 2; ++q) *(f32x4*)(row + 512 * j + 8 * lane + 4 * q) = (f32x4){v[4 * j + 2 * q][0], v[4 * j + 2 * q][1], v[4 * j + 2 * q + 1][0], v[4 * j + 2 * q + 1][1]};
}
__device__ __forceinline__ void p9_combine_ln(const Ctx& F, int l, bool dry) {
    bf16_t* X = (bf16_t*)(F.ws + WS_X); bf16_t* XO = dry ? (bf16_t*)(F.ws + WS_PRE) : X; float* FO = F.out; const unsigned char* YB = F.ws + WS_YB;
    float* GATES = (float*)(F.ws + WS_GATES); unsigned char* XF = F.ws + (dry ? WS_PRE + 128 * MiB - 64 * MiB : WS_XF);
    LAS float* wif = (LAS float*)F.lds;
    const bool lastl = (l == DEPTH - 1);
    LAS float* gb = (LAS float*)(F.lds + 32768);
    const int gw = F.wg * NWAVES + F.wave, NGW = F.G * NWAVES, npair = M / (2 * NGW);
    const bf16_t* PREp = (const bf16_t*)(F.ws + WS_PRE); LAS float* gm = gb + 2048;
    struct RawRows { u32x4 x[2][2]; u32x2 y[2][2][2]; f32x2 s[2]; };
    RawRows rawA, rawB;
#define P9_LOADS(it_, raw) do { _Pragma("unroll") for (int rr = 0; rr < 2; ++rr) { const size_t o_ = (size_t)(gw + NGW * (2 * (it_) + rr)) * D + 8 * F.lane; \
        raw.x[rr][0] = *(const u32x4*)(PREp + o_); raw.x[rr][1] = *(const u32x4*)(PREp + o_ + 512); raw.s[rr] = *(const f32x2*)(F.ws + WS_RE + (size_t)(gw + NGW * (2 * (it_) + rr)) * 8); \
        raw.y[rr][0][0] = *(const u32x2*)(YB + o_); raw.y[rr][0][1] = *(const u32x2*)(YB + o_ + 512); \
        raw.y[rr][1][0] = *(const u32x2*)(YB + (size_t)M * D + o_); raw.y[rr][1][1] = *(const u32x2*)(YB + (size_t)M * D + o_ + 512); } } while (0)
#define P9_XP(w_) ((f32x2){__uint_as_float((w_) << 16), __uint_as_float((w_) & 0xffff0000u)})
#define P9_COMB(dst, xw_, y0w_, y1w_, hi_, a2_, b2_) do { const f32x2 ya_ = __builtin_amdgcn_cvt_pk_f32_fp8((int)(y0w_), hi_), yb_ = __builtin_amdgcn_cvt_pk_f32_fp8((int)(y1w_), hi_); \
        dst = P9_XP(xw_) * (a2_) + ((ya_ + yb_) * (f32x2){1.0f / YB_SCALE, 1.0f / YB_SCALE} + (b2_)); } while (0)
#define P9_STEP(k_, raw) do { const int k = (k_); f32x2 v[2][8]; \
        _Pragma("unroll") for (int rr = 0; rr < 2; ++rr) \
            _Pragma("unroll") for (int j = 0; j < 2; ++j) { const u32x4 xw = raw.x[rr][j]; const u32x2 y0w = raw.y[rr][0][j], y1w = raw.y[rr][1][j]; \
                const float ar_ = ALPHA * raw.s[rr][1], mn_ = raw.s[rr][0]; f32x2 a2[4], b2[4]; \
                _Pragma("unroll") for (int hf = 0; hf < 2; ++hf) { const f32x4 g4 = *(LAS const f32x4*)(gm + (2 * j + hf) * 256 + F.lane * 4), c4 = *(LAS const f32x4*)(gm + (4 + 2 * j + hf) * 256 + F.lane * 4); \
                    a2[2 * hf] = (f32x2){g4[0], g4[1]} * ar_; a2[2 * hf + 1] = (f32x2){g4[2], g4[3]} * ar_; b2[2 * hf] = (f32x2){c4[0], c4[1]} - a2[2 * hf] * mn_; b2[2 * hf + 1] = (f32x2){c4[2], c4[3]} - a2[2 * hf + 1] * mn_; } \
                P9_COMB(v[rr][4 * j], xw.x, y0w.x, y1w.x, false, a2[0], b2[0]); P9_COMB(v[rr][4 * j + 1], xw.y, y0w.x, y1w.x, true, a2[1], b2[1]); \
                P9_COMB(v[rr][4 * j + 2], xw.z, y0w.y, y1w.y, false, a2[2], b2[2]); P9_COMB(v[rr][4 * j + 3], xw.w, y0w.y, y1w.y, true, a2[3], b2[3]); } \
        if (k + 2 < npair) P9_LOADS(k + 2, raw); \
        _Pragma("unroll") for (int rr = 0; rr < 2; ++rr) { const int m = gw + NGW * (2 * k + rr); ln_inplace_lds2(v[rr], gb, F.lane); \
            if (lastl) store_row_f32_2(FO + (size_t)m * D, F.lane, v[rr]); else { store_row_bf16_2(XO + (size_t)m * D, F.lane, v[rr]); \
                _Pragma("unroll") for (int j = 0; j < 2; ++j) { u32x2 f8; f8.x = pack4_fp8c((f32x4){v[rr][4 * j][0], v[rr][4 * j][1], v[rr][4 * j + 1][0], v[rr][4 * j + 1][1]}, 1.0f); f8.y = pack4_fp8c((f32x4){v[rr][4 * j + 2][0], v[rr][4 * j + 2][1], v[rr][4 * j + 3][0], v[rr][4 * j + 3][1]}, 1.0f); \
                    *(u32x2*)(XF + (size_t)m * D + 512 * j + 8 * F.lane) = f8; } } } \
        if (!lastl) { float part[16]; row_dots2<8>(v, wif, F.lane, part); \
            const float tot = reduce16(part, F.lane); \
            if ((F.lane & 3) == 0) { const int ix = idx16(F.lane), rr = ix >> 3, j = ix & 7; GATES[(size_t)(gw + NGW * (2 * k + rr)) * 8 + j] = tot + F.b_in[(size_t)(l + 1) * PIN + SRC_IF + j]; } } } while (0)
    P9_LOADS(0, rawA); P9_LOADS(1, rawB);
    if (!lastl) { const f32x4* src = (const f32x4*)(F.ws + WS_WIFP) + (size_t)(l + 1) * 2 * D;
#pragma unroll
        for (int j = 0; j < 4; ++j) *(LAS f32x4*)(wif + 4 * (F.tid + NTHR * j)) = src[F.tid + NTHR * j]; }
    for (int k = F.tid; k < D; k += NTHR) { gb[wperm_idx(0, k)] = F.ln_moe_g[(size_t)l * D + k]; gb[wperm_idx(1, k)] = F.ln_moe_b[(size_t)l * D + k]; }
    for (int k = F.tid; k < D; k += NTHR) { gm[wperm_idx(0, k)] = F.ln_mix_g[(size_t)l * D + k]; gm[wperm_idx(1, k)] = ALPHA * F.ln_mix_b[(size_t)l * D + k]; }
    __syncthreads();
    for (int it = 0; it < npair; it += 2) { P9_STEP(it, rawA); P9_STEP(it + 1, rawB); }
#undef P9_LOADS
#undef P9_XP
#undef P9_COMB
#undef P9_STEP
}

__global__ void __launch_bounds__(NTHR, 2) fwd(Args args) {
    extern __shared__ __attribute__((aligned(16))) unsigned char lds_raw[];
    Ctx F;
    F.lds = (LAS unsigned char*)lds_raw;
    F.tid = threadIdx.x; F.lane = F.tid & 63; F.wave = __builtin_amdgcn_readfirstlane(F.tid >> 6); F.G = gridDim.x; F.wg = blockIdx.x;
typedef unsigned long long u64x8 __attribute__((ext_vector_type(8)));
    typedef unsigned long long u64x2 __attribute__((ext_vector_type(2)));
#define PTRG(T, v) ((T)(GAS T)(v))
#define REFRESH() do { F.tid = opaque_tid(); F.lane = F.tid & 63; F.wave = __builtin_amdgcn_readfirstlane(F.tid >> 6); \
        u64x8 _a, _b; u64x2 _c; \
        asm volatile("s_load_dwordx16 %0, %3, 0x0\n\ts_load_dwordx16 %1, %3, 0x40\n\ts_load_dwordx4 %2, %3, 0x80\n\ts_waitcnt lgkmcnt(0)" : "=&s"(_a), "=&s"(_b), "=&s"(_c) : "s"(__builtin_amdgcn_kernarg_segment_ptr())); \
        F.x = PTRG(const float*, _a[0]); F.w_in = PTRG(const float*, _a[1]); F.b_in = PTRG(const float*, _a[2]); F.conv_w = PTRG(const float*, _a[3]); F.mh_g = PTRG(const float*, _a[4]); F.w_out = PTRG(const float*, _a[5]); \
        F.ln_mix_g = PTRG(const float*, _a[6]); F.ln_mix_b = PTRG(const float*, _a[7]); F.router_w = PTRG(const float*, _b[0]); F.router_b = PTRG(const float*, _b[1]); F.w_gate = PTRG(const float*, _b[2]); F.w_up = PTRG(const float*, _b[3]); \
        F.w_down = PTRG(const float*, _b[4]); F.ln_moe_g = PTRG(const float*, _b[5]); F.ln_moe_b = PTRG(const float*, _b[6]); F.out = PTRG(float*, _b[7]); F.ws = PTRG(unsigned char*, _c[0]); } while (0)
    F.x = args.in[0]; F.w_in = args.in[1]; F.b_in = args.in[2]; F.conv_w = args.in[3]; F.mh_g = args.in[4]; F.w_out = args.in[5]; F.ln_mix_g = args.in[6]; F.ln_mix_b = args.in[7];
    F.router_w = args.in[8]; F.router_b = args.in[9]; F.w_gate = args.in[10]; F.w_up = args.in[11]; F.w_down = args.in[12]; F.ln_moe_g = args.in[13]; F.ln_moe_b = args.in[14];
    F.out = args.out; F.ws = args.ws;
    for (int u = F.tid; u < (LDS_BYTES - MISC_OFF) / 4; u += NTHR) ((LAS unsigned*)(F.lds + MISC_OFF))[u] = 0u;
    __syncthreads();
    XcdBarrier bar; bar.bar = (unsigned*)(F.ws + WS_CTL) + CW_BAR + args.li * XCD_BAR_WORDS; bar.x = 0; bar.st = (volatile LAS unsigned*)(F.lds + MISC_OFF);
    const int lo = args.ph_lo, hi = args.ph_hi;
    if (hi - lo > 1) bar = xcd_barrier_post((unsigned*)(F.ws + WS_CTL) + CW_BAR + args.li * XCD_BAR_WORDS, (volatile LAS unsigned*)(F.lds + MISC_OFF));
#define IN(k) (lo <= (k) && (k) < hi)
#define SEAM(k) do { if (IN(k) && IN((k) + 1)) xcd_barrier(bar); } while (0)
    LAS const int* tab = (LAS const int*)(F.lds + MISC_OFF + 64);
    LAS int* toks = (LAS int*)(F.lds + TOK_OFF);

    if (EN(0) && IN(0))
#pragma unroll 1
    for (int rep = 0; rep < REPS(0); ++rep) { REFRESH(); p0_prologue(F); __syncthreads(); }
    SEAM(0);
    for (int l = 0; l < DEPTH; ++l) {
        const int pb = 1 + 9 * l;
        if (EN(1) && IN(pb + 0))
#pragma unroll 1
        for (int rep = 0; rep < REPS(1); ++rep) {
            REFRESH();
            pg8::DenseOrder S; S.nM = M / 256; S.nN = NP / 256; S.nwg = S.nM * S.nN; S.G = F.G; S.c = F.wg; S.lda = D / 2; S.K = D / 2; S.Bt = (const bf16_t*)(F.ws + WS_WIN) + (size_t)l * NP * (D / 2);
            { LAS float* bl = (LAS float*)(F.lds + BIAS_OFF); const float* bsrc = F.b_in + (size_t)l * PIN;
              for (int i = F.tid; i < NP; i += NTHR) bl[i] = bsrc[win_src_col(i)];
              __syncthreads(); }
            pg8::EpiInProj E{(bf16_t*)(F.ws + WS_P), F.ws + WS_CV, (LAS const float*)(F.lds + BIAS_OFF)};
            pg8::gemm_phase<pg8::EpiInProj, pg8::DenseOrder>(F.lds, (const bf16_t*)(F.ws + WS_XF), S, E);
        }
        SEAM(pb + 0);
        if (EN(2) && IN(pb + 1))
#pragma unroll 1
        for (int rep = 0; rep < REPS(2); ++rep) { REFRESH(); p2_local_conv(F, l); }
        SEAM(pb + 1);
        if (EN(3) && IN(pb + 2))
#pragma unroll 1
        for (int rep = 0; rep < REPS(3); ++rep) { REFRESH(); p3_scan(F); }
        SEAM(pb + 2);
        if (EN(4) && IN(pb + 3))
#pragma unroll 1
        for (int rep = 0; rep < REPS(4); ++rep) { REFRESH(); p4_mlstm_out(F, l); }
        SEAM(pb + 3);
        if (EN(5) && IN(pb + 4))
#pragma unroll 1
        for (int rep = 0; rep < REPS(5); ++rep) {
            REFRESH();
            pg8::DenseOrder S; S.nM = M / 256; S.nN = D / 256; S.nwg = S.nM * S.nN; S.G = F.G; S.c = F.wg; S.lda = D / 2; S.K = D / 2; S.Bt = (const bf16_t*)(F.ws + WS_WOUT) + (size_t)l * D * (D / 2);
            pg8::EpiOutProj E{(bf16_t*)(F.ws + WS_PRE), (const bf16_t*)(F.ws + WS_X)};
            pg8::gemm_phase<pg8::EpiOutProj, pg8::DenseOrder>(F.lds, (const bf16_t*)F.out, S, E);
        }
        SEAM(pb + 4);
        if (EN(6) && IN(pb + 5))
#pragma unroll 1
        for (int rep = REPS(6) - 1; rep >= 0; --rep) { REFRESH(); p6_ln_router(F, l, l + 4 * rep); __syncthreads(); }
        SEAM(pb + 5);
        if (EN(7) && IN(pb + 6))
#pragma unroll 1
        for (int pass = 0; pass < 2; ++pass) {
            REFRESH();
            if (pass == 0) moe_tables(F, l);
            const int nwg7 = __builtin_amdgcn_readfirstlane(tab[32]) * 4, R7 = nwg7 / F.G, L7 = nwg7 - R7 * F.G;
            if (pass == 0 || F.wg < L7) {
                pg8::MoeOrder<true> S; S.nM = tab[32]; S.nN = 4; S.nwg = nwg7; S.G = F.G; S.c = F.wg; S.lda = D / 2; S.K = D / 2; S.Bt = (const bf16_t*)(F.ws + WS_WGU) + (size_t)l * NE * 1024 * (D / 2); S.estride = (size_t)1024 * (D / 2); S.tab = tab; S.toks = toks;
                S.i0 = pass ? R7 : 0; S.ni = pass ? 1 : R7; S.L = 0; S.lmask = (LAS const unsigned*)(F.lds + MISC_OFF + 256); S.left = (unsigned*)(F.ws + WS_CTL) + CW_LEFT + l;
                const int* TL = (const int*)(F.ws + WS_TLIST);
                { int vals[MAXU / 2];
#pragma unroll
                  for (int j = 0; j < MAXU / 2; ++j) { pg8::Unit u{0, 0, 0, 0, 0}; const bool ok = S.next(2 * j + (F.tid >> 8), u); const int slot = u.rb * 256 + (F.tid & 255); const bool live = ok && slot < tab[u.e];
                      const int v = TL[live ? (size_t)u.e * M + slot : (size_t)0]; vals[j] = live ? (v >> 1) : 0; }
#pragma unroll
                  for (int j = 0; j < MAXU / 2; ++j) toks[(2 * j + (F.tid >> 8)) * 256 + (F.tid & 255)] = vals[j]; }
                __syncthreads();
                pg8::EpiGateUp E{F.ws + WS_HDN};
                pg8::gemm_phase<pg8::EpiGateUp, pg8::MoeOrder<true>>(F.lds, (const bf16_t*)((const unsigned char*)F.out + X1F_OFF), S, E);
                if (pass) {
                    VM_WAIT(); __syncthreads();
                    if (F.tid == 0) { __builtin_amdgcn_fence(__ATOMIC_RELEASE, "agent"); VM_WAIT(); (void)xb_add((unsigned*)(F.ws + WS_CTL) + CW_LEFT + l, 1u); }
                }
            }
            if (pass == 0) SEAM(pb + 6);
        }
        if (EN(8) && IN(pb + 7))
#pragma unroll 1
        for (int rep = 0; rep < REPS(8); ++rep) {
            REFRESH();
            if (MK_PER_PHASE) moe_tables(F, l);
            const int nwg7 = __builtin_amdgcn_readfirstlane(tab[32]) * 4, R7 = nwg7 / F.G, L7 = nwg7 - R7 * F.G;
            { LAS unsigned* lm = (LAS unsigned*)(F.lds + MISC_OFF + 256);
              __syncthreads();
              if (F.tid < 32) lm[F.tid] = 0u;
              __syncthreads();
              if (F.tid < L7) { pg8::Unit u{0, 0, 0, 0, 0}; pg8::static_unit(tab[32], 4, R7 * F.G + F.tid, u); atomicOr((unsigned*)(lm + (u.pm >> 5)), 1u << (u.pm & 31)); }
              __syncthreads(); }
            pg8::MoeOrder<false> S; S.nM = tab[32]; S.nN = 4; S.nwg = S.nM * 4; S.G = F.G; S.c = F.wg; S.lda = DFF / 2; S.K = DFF / 2; S.Bt = (const bf16_t*)(F.ws + WS_WDN) + (size_t)l * NE * D * (DFF / 2); S.estride = (size_t)D * (DFF / 2); S.tab = tab; S.toks = toks;
            S.i0 = 0; S.ni = 0; S.L = L7; S.lmask = (LAS const unsigned*)(F.lds + MISC_OFF + 256); S.left = (unsigned*)(F.ws + WS_CTL) + CW_LEFT + l;
            { const float* GLp = (const float*)(F.ws + WS_GLIST); LAS float* gts = (LAS float*)(F.lds + TOK_OFF);
              const int* TLp = (const int*)(F.ws + WS_TLIST); LAS int* dsts = (LAS int*)(F.lds + BIAS_OFF);
              float vals[MAXU / 2]; int dv[MAXU / 2];
#pragma unroll
              for (int j = 0; j < MAXU / 2; ++j) { pg8::Unit u{0, 0, 0, 0, 0}; const bool ok = S.next(2 * j + (F.tid >> 8), u); const int slot = u.rb * 256 + (F.tid & 255); const bool live = ok && slot < tab[u.e];
                  const float v = GLp[live ? (size_t)u.e * M + slot : (size_t)0]; const int d = TLp[live ? (size_t)u.e * M + slot : (size_t)0]; vals[j] = live ? v : 0.f; dv[j] = live ? d : -1; }
#pragma unroll
              for (int j = 0; j < MAXU / 2; ++j) { gts[(2 * j + (F.tid >> 8)) * 256 + (F.tid & 255)] = vals[j]; dsts[(2 * j + (F.tid >> 8)) * 256 + (F.tid & 255)] = dv[j]; }
              __syncthreads(); }
            pg8::EpiDown E{F.ws + WS_YB, (LAS const float*)(F.lds + TOK_OFF), (LAS const int*)(F.lds + BIAS_OFF)};
            pg8::gemm_phase<pg8::EpiDown, pg8::MoeOrder<false>>(F.lds, (const bf16_t*)(F.ws + WS_HDN), S, E);
        }
        SEAM(pb + 7);
        if (EN(9) && IN(pb + 8))
#pragma unroll 1
        for (int rep = REPS(9) - 1; rep >= 0; --rep) { REFRESH(); p9_combine_ln(F, l, rep != 0); __syncthreads(); }
        SEAM(pb + 8);
    }
#undef IN
#undef SEAM
}

extern "C" void kernel_launch(void* const* d_in, const int* in_sizes, int n_in, void* d_out, int out_size, void* d_ws, size_t ws_size, hipStream_t stream) {
    static int grid = 0;
    if (grid == 0) {
        if (n_in != 15 || in_sizes[0] != M * D || out_size != M * D || ws_size < WS_END) { fprintf(stderr, "kernel_launch: unexpected shapes (n_in %d, in0 %d, out %d, ws %zu)\n", n_in, n_in > 0 ? in_sizes[0] : -1, out_size, ws_size); grid = -1; return; }
        int dev = 0, cus = 0, per_cu = 0;
        if (hipGetDevice(&dev) != hipSuccess || hipDeviceGetAttribute(&cus, hipDeviceAttributeMultiprocessorCount, dev) != hipSuccess) { grid = -1; return; }
        if (hipFuncSetAttribute((const void*)fwd, hipFuncAttributeMaxDynamicSharedMemorySize, LDS_BYTES) != hipSuccess) { fprintf(stderr, "kernel_launch: hipFuncSetAttribute failed\n"); grid = -1; return; }
        if (hipOccupancyMaxActiveBlocksPerMultiprocessor(&per_cu, (const void*)fwd, NTHR, LDS_BYTES) != hipSuccess || per_cu < 1) fprintf(stderr, "kernel_launch: occupancy query says %d\n", per_cu);
        (void)hipGetLastError();
        grid = cus;
        if (grid > 256) grid = 256;
        if (grid != 256) { fprintf(stderr, "kernel_launch: %d CUs: this kernel is sized for 256\n", grid); grid = -1; return; }
    }
    if (grid < 0) return;
    if (hipMemsetAsync((char*)d_ws + WS_CTL, 0, CTL_ZERO_BYTES, stream) != hipSuccess) return;
    Args a{};
    for (int i = 0; i < 15; ++i) a.in[i] = (const float*)d_in[i];
    a.out = (float*)d_out; a.ws = (unsigned char*)d_ws; a.pad = 0;
#if MK_PER_PHASE
    for (int p = 0; p < NPHASE; ++p) { a.ph_lo = p; a.ph_hi = p + 1; a.li = 0; hipLaunchKernelGGL(fwd, dim3(grid), dim3(NTHR), LDS_BYTES, stream, a); }
#else
    a.ph_lo = 0; a.ph_hi = NPHASE; a.li = 0;
    hipLaunchKernelGGL(fwd, dim3(grid), dim3(NTHR), LDS_BYTES, stream, a);
#endif
}
```
